# Optimizing an MI355X kernel written in HIP

```python
import math
import jax, jax.numpy as jnp
from jax import lax
import numpy as np

D_MODEL = 1024
BATCH = 32
SEQ = 2048
DEPTH = 4

NORM_EPS = 1e-6
NEG_INF = -1e30
Q_BLOCK = 128
PLE_DIM = 256
D_FF = 2816
MLA_NOPE = 64
MLA_ROPE = 32
MLA_V = 64
MLA_HEADS = D_MODEL // MLA_V
MLA_Q_LORA = 384
MLA_KV_LORA = 256
ROPE_THETA = 10000.0
SWA_HEAD_DIM = 64
SWA_HEADS = D_MODEL // SWA_HEAD_DIM
SWA_KV_HEADS = 4
WINDOW = 128
DIFF_HEAD_DIM = 64
DIFF_HEADS = D_MODEL // (2 * DIFF_HEAD_DIM)
REL_BUCKETS = 32
REL_MAX_DIST = 128

IN_WIDTHS = (MLA_Q_LORA, MLA_KV_LORA, MLA_ROPE,
             SWA_HEADS * SWA_HEAD_DIM, SWA_KV_HEADS * SWA_HEAD_DIM, SWA_KV_HEADS * SWA_HEAD_DIM,
             DIFF_HEADS * 2 * DIFF_HEAD_DIM, DIFF_HEADS * 2 * DIFF_HEAD_DIM, DIFF_HEADS * 2 * DIFF_HEAD_DIM,
             D_MODEL, D_MODEL, D_MODEL)
IN_WIDTH = sum(IN_WIDTHS)
IN_SPLITS = tuple(int(v) for v in np.cumsum(IN_WIDTHS)[:-1])

kernel_name = 'hybrid_gated_mla_swa_diff_encoder'


def rms_norm(x, gain):
    x32 = x.astype(jnp.float32)
    y = x32 * lax.rsqrt(jnp.mean(x32 * x32, axis=-1, keepdims=True) + NORM_EPS)
    return (y * gain.astype(jnp.float32)).astype(x.dtype)


def swiglu(x, w_gate, w_up, w_down):
    return (jax.nn.silu(x @ w_gate) * (x @ w_up)) @ w_down


def t5_bucket(rel):
    nb = REL_BUCKETS // 2
    max_exact = nb // 2
    base = jnp.where(rel > 0, nb, 0)
    n = jnp.abs(rel)
    nf = jnp.maximum(n, 1).astype(jnp.float32)
    large = max_exact + (jnp.log(nf / max_exact) / math.log(REL_MAX_DIST / max_exact) * (nb - max_exact)).astype(jnp.int32)
    large = jnp.minimum(large, nb - 1)
    return base + jnp.where(n < max_exact, n, large)


def rel_bias(table, rel):
    return jnp.moveaxis(table[t5_bucket(rel)], -1, 0).astype(jnp.float32)


def rope_angles(seq_len):
    inv = ROPE_THETA ** (-jnp.arange(0, MLA_ROPE, 2, dtype=jnp.float32) / MLA_ROPE)
    ang = jnp.arange(seq_len, dtype=jnp.float32)[:, None] * inv[None, :]
    return jnp.cos(ang), jnp.sin(ang)


def apply_rope(x, cos, sin):
    x1, x2 = jnp.split(x.astype(jnp.float32), 2, axis=-1)
    return jnp.concatenate([x1 * cos - x2 * sin, x2 * cos + x1 * sin], axis=-1).astype(x.dtype)


def to_blocks(x):
    b, s = x.shape[:2]
    return jnp.moveaxis(x.reshape(b, s // Q_BLOCK, Q_BLOCK, *x.shape[2:]), 1, 0)


def from_blocks(y):
    y = jnp.moveaxis(y, 0, 1)
    return y.reshape(y.shape[0], y.shape[1] * y.shape[2], *y.shape[3:])


def mla_attention(c_q, c_kv, k_rope, q_norm, w_uq, kv_norm, w_ukv, cos, sin):
    b, s, _ = c_q.shape
    q = (rms_norm(c_q, q_norm) @ w_uq).reshape(b, s, MLA_HEADS, MLA_NOPE + MLA_ROPE)
    q_nope = q[..., :MLA_NOPE]
    q_rope = apply_rope(q[..., MLA_NOPE:], cos[:, None, :], sin[:, None, :])
    kv = (rms_norm(c_kv, kv_norm) @ w_ukv).reshape(b, s, MLA_HEADS, MLA_NOPE + MLA_V)
    k_nope, v = kv[..., :MLA_NOPE], kv[..., MLA_NOPE:]
    k_rope = apply_rope(k_rope, cos, sin)
    scale = (MLA_NOPE + MLA_ROPE) ** -0.5

    def block(args):
        qn, qr = args
        logits = (jnp.einsum('bqhd,bkhd->bhqk', qn, k_nope)
                  + jnp.einsum('bqhr,bkr->bhqk', qr, k_rope)).astype(jnp.float32) * scale
        probs = jax.nn.softmax(logits, axis=-1).astype(v.dtype)
        return jnp.einsum('bhqk,bkhd->bqhd', probs, v)

    out = lax.map(block, (to_blocks(q_nope), to_blocks(q_rope)))
    return from_blocks(out).reshape(b, s, MLA_HEADS * MLA_V)


def window_gqa(q, k, v, sink, bias_table):
    b, s = q.shape[:2]
    g = SWA_HEADS // SWA_KV_HEADS
    span = Q_BLOCK + 2 * WINDOW
    pad = ((0, 0), (WINDOW, WINDOW), (0, 0), (0, 0))
    kp, vp = jnp.pad(k, pad), jnp.pad(v, pad)
    qb = to_blocks(q.reshape(b, s, SWA_KV_HEADS, g, SWA_HEAD_DIM))
    scale = SWA_HEAD_DIM ** -0.5
    sink = sink.reshape(SWA_KV_HEADS, g).astype(jnp.float32)
    q_off = jnp.arange(Q_BLOCK)
    k_off = jnp.arange(span) - WINDOW

    def block(args):
        j, qj = args
        start = j * Q_BLOCK
        kj = lax.dynamic_slice_in_dim(kp, start, span, axis=1)
        vj = lax.dynamic_slice_in_dim(vp, start, span, axis=1)
        q_pos = start + q_off
        k_pos = start + k_off
        rel = k_pos[None, :] - q_pos[:, None]
        valid = (jnp.abs(rel) <= WINDOW) & (k_pos >= 0)[None, :] & (k_pos < s)[None, :]
        bias = rel_bias(bias_table, rel).reshape(SWA_KV_HEADS, g, Q_BLOCK, span)
        logits = jnp.einsum('bqkgd,bskd->bkgqs', qj, kj).astype(jnp.float32) * scale + bias
        logits = jnp.where(valid, logits, NEG_INF)
        sink_col = jnp.broadcast_to(sink[None, :, :, None, None], logits.shape[:-1] + (1,))
        probs = jax.nn.softmax(jnp.concatenate([logits, sink_col], axis=-1), axis=-1)[..., :span]
        return jnp.einsum('bkgqs,bskd->bqkgd', probs.astype(vj.dtype), vj)

    out = lax.map(block, (jnp.arange(s // Q_BLOCK), qb))
    return from_blocks(out).reshape(b, s, SWA_HEADS * SWA_HEAD_DIM)


def diff_attention(q, k, v, lq1, lk1, lq2, lk2, subln, lambda_init, bias_table):
    b, s = q.shape[:2]
    f32 = jnp.float32
    lam = (jnp.exp(jnp.sum(lq1.astype(f32) * lk1.astype(f32)))
           - jnp.exp(jnp.sum(lq2.astype(f32) * lk2.astype(f32))) + lambda_init)
    scale = DIFF_HEAD_DIM ** -0.5
    k_pos = jnp.arange(s)

    def block(args):
        j, qj = args
        q_pos = j * Q_BLOCK + jnp.arange(Q_BLOCK)
        bias = rel_bias(bias_table, k_pos[None, :] - q_pos[:, None])
        logits = jnp.einsum('bqhcd,bkhcd->bchqk', qj, k).astype(f32) * scale + bias
        probs = jax.nn.softmax(logits, axis=-1)
        attn = probs[:, 0] - lam * probs[:, 1]
        return jnp.einsum('bhqk,bkhe->bqhe', attn.astype(v.dtype), v)

    out = from_blocks(lax.map(block, (jnp.arange(s // Q_BLOCK), to_blocks(q))))
    out = rms_norm(out, subln) * (1.0 - lambda_init)
    return out.reshape(b, s, DIFF_HEADS * 2 * DIFF_HEAD_DIM)


def setup_inputs(seed: int = 0) -> dict:
    key = jax.random.key(seed)
    ks = iter(jax.random.split(key, 64))

    def normal(shape, scale):
        return jax.random.normal(next(ks), shape, jnp.float32) * scale

    def gain(shape):
        return 1.0 + normal(shape, 0.02)

    L, D, F = DEPTH, D_MODEL, D_FF
    dd = DIFF_HEAD_DIM
    return {
        'x': normal((BATCH, SEQ, D), 1.0),
        'p': normal((DEPTH, BATCH, SEQ, PLE_DIM), 1.0),
        'ffn1_norm': gain((L, D)),
        'ffn1_w_gate': normal((L, D, F), D ** -0.5),
        'ffn1_w_up': normal((L, D, F), D ** -0.5),
        'ffn1_w_down': normal((L, F, D), F ** -0.5),
        'mix_norm': gain((L, D)),
        'w_in': normal((L, D, IN_WIDTH), D ** -0.5),
        'mla_q_norm': gain((L, MLA_Q_LORA)),
        'mla_w_uq': normal((L, MLA_Q_LORA, MLA_HEADS * (MLA_NOPE + MLA_ROPE)), MLA_Q_LORA ** -0.5),
        'mla_kv_norm': gain((L, MLA_KV_LORA)),
        'mla_w_ukv': normal((L, MLA_KV_LORA, MLA_HEADS * (MLA_NOPE + MLA_V)), MLA_KV_LORA ** -0.5),
        'swa_sink': normal((L, SWA_HEADS), 0.5),
        'diff_lambda_q1': normal((L, dd), 0.1),
        'diff_lambda_k1': normal((L, dd), 0.1),
        'diff_lambda_q2': normal((L, dd), 0.1),
        'diff_lambda_k2': normal((L, dd), 0.1),
        'diff_subln': gain((L, 2 * dd)),
        'rel_table': normal((REL_BUCKETS, SWA_HEADS + DIFF_HEADS), 0.2),
        'w_out': normal((L, D, D), D ** -0.5),
        'ffn2_norm': gain((L, D)),
        'ffn2_w_gate': normal((L, D, F), D ** -0.5),
        'ffn2_w_up': normal((L, D, F), D ** -0.5),
        'ffn2_w_down': normal((L, F, D), F ** -0.5),
        'ple_norm': gain((L, D)),
        'ple_w_gate': normal((L, D, D), D ** -0.5),
        'ple_w_proj': normal((L, PLE_DIM, D), PLE_DIM ** -0.5),
        'final_norm': gain((D,)),
    }


def reference(x, p, ffn1_norm, ffn1_w_gate, ffn1_w_up, ffn1_w_down, mix_norm, w_in,
              mla_q_norm, mla_w_uq, mla_kv_norm, mla_w_ukv, swa_sink,
              diff_lambda_q1, diff_lambda_k1, diff_lambda_q2, diff_lambda_k2, diff_subln,
              rel_table, w_out, ffn2_norm, ffn2_w_gate, ffn2_w_up, ffn2_w_down,
              ple_norm, ple_w_gate, ple_w_proj, final_norm):
    b, s, _ = x.shape
    cos, sin = rope_angles(s)
    table_b = rel_table[:, :SWA_HEADS]
    table_c = rel_table[:, SWA_HEADS:]
    h = x
    for i in range(DEPTH):
        h = h + 0.5 * swiglu(rms_norm(h, ffn1_norm[i]), ffn1_w_gate[i], ffn1_w_up[i], ffn1_w_down[i])

        u = rms_norm(h, mix_norm[i])
        proj = u @ w_in[i]
        (c_q, c_kv, k_rope, q_b, k_b, v_b, q_c, k_c, v_c,
         g_a, g_b, g_c) = jnp.split(proj, IN_SPLITS, axis=-1)

        o_a = mla_attention(c_q, c_kv, k_rope, mla_q_norm[i], mla_w_uq[i],
                            mla_kv_norm[i], mla_w_ukv[i], cos, sin)
        o_b = window_gqa(q_b.reshape(b, s, SWA_HEADS, SWA_HEAD_DIM),
                         k_b.reshape(b, s, SWA_KV_HEADS, SWA_HEAD_DIM),
                         v_b.reshape(b, s, SWA_KV_HEADS, SWA_HEAD_DIM),
                         swa_sink[i], table_b)
        lambda_init = 0.8 - 0.6 * math.exp(-0.3 * i)
        o_c = diff_attention(q_c.reshape(b, s, DIFF_HEADS, 2, DIFF_HEAD_DIM),
                             k_c.reshape(b, s, DIFF_HEADS, 2, DIFF_HEAD_DIM),
                             v_c.reshape(b, s, DIFF_HEADS, 2 * DIFF_HEAD_DIM),
                             diff_lambda_q1[i], diff_lambda_k1[i], diff_lambda_q2[i], diff_lambda_k2[i],
                             diff_subln[i], lambda_init, table_c)

        merged = jax.nn.sigmoid(g_a) * o_a + jax.nn.sigmoid(g_b) * o_b + jax.nn.sigmoid(g_c) * o_c
        h = h + merged @ w_out[i]

        h = h + 0.5 * swiglu(rms_norm(h, ffn2_norm[i]), ffn2_w_gate[i], ffn2_w_up[i], ffn2_w_down[i])

        gate = jax.nn.sigmoid(rms_norm(h, ple_norm[i]) @ ple_w_gate[i])
        h = h + gate * (p[i] @ ple_w_proj[i])
    return rms_norm(h, final_norm)
```

```cpp
#include <hip/hip_runtime.h>
#include <hip/hip_cooperative_groups.h>
#include <cstdio>
#include <cstdint>
#include <cmath>
namespace cg = cooperative_groups;

#define LAS __attribute__((address_space(3)))
typedef unsigned short bf16_t;
typedef short bf16x8 __attribute__((ext_vector_type(8)));
typedef float f32x4 __attribute__((ext_vector_type(4)));
typedef float f32x16 __attribute__((ext_vector_type(16)));
typedef unsigned u32x4 __attribute__((ext_vector_type(4)));
typedef unsigned u32x2 __attribute__((ext_vector_type(2)));
typedef short v4i16_t __attribute__((ext_vector_type(4)));
typedef float f32x2_t __attribute__((ext_vector_type(2)));
typedef __bf16 bf16x2_t __attribute__((ext_vector_type(2)));

constexpr int DM = 1024, SEQ = 2048, DEPTH = 4, MTOK = 65536, DFF = 2816, PLE = 256;
constexpr int NB_CHUNK = 16, MC = NB_CHUNK * SEQ, NCHUNK = 2;
constexpr int INW = 8352, INP = 8448;
constexpr int C_CQ = 0, C_CKV = 384, C_KR = 640, C_QB = 768, C_KB = 1792, C_VB = 2048, C_QC = 2304, C_KC = 3328, C_VC = 4352, C_GA = 5376, C_GB = 6400, C_GC = 7424;
constexpr int QAW = 1536, KVAW = 2048;
constexpr float EPS = 1e-6f;
constexpr float LOG2E = 1.4426950408889634f;
constexpr float C2_64 = 0.125f * 1.4426950408889634f;
constexpr float C2_96 = 0.10206207261596577f * 1.4426950408889634f;

constexpr size_t MiB = 1u << 20;
constexpr size_t WS_PH0 = 0, WS_PQ = 4 * MiB, WS_PKV = 6 * MiB;
constexpr size_t WS_PH1 = 1012 * MiB, WS_PH2 = 1016 * MiB, WS_PH3 = 1020 * MiB;
constexpr size_t WS_ROPE = 7 * MiB;
constexpr size_t WS_BAR = 7 * MiB + 512 * 1024;
constexpr size_t WS_W = 8 * MiB;
constexpr size_t WS_PB = 66 * MiB;
constexpr size_t WS_HB = 98 * MiB;
constexpr size_t WS_ACT = 226 * MiB;
constexpr size_t WS_QA = 754 * MiB;
constexpr size_t WS_KVA = 850 * MiB;
constexpr size_t WS_HID = 226 * MiB;
constexpr size_t WS_PPJ = 578 * MiB;
constexpr size_t WS_SCR = 980 * MiB;
constexpr size_t WS_END = 1024 * MiB;
constexpr size_t W_GU1 = 0, W_D1 = W_GU1 + (size_t)2 * DFF * DM, W_IN = W_D1 + (size_t)DM * DFF, W_UQ = W_IN + (size_t)INP * DM,
                 W_UKV = W_UQ + (size_t)QAW * 384, W_OUT = W_UKV + (size_t)KVAW * 256, W_GU2 = W_OUT + (size_t)DM * DM,
                 W_D2 = W_GU2 + (size_t)2 * DFF * DM, W_PG = W_D2 + (size_t)DM * DFF, W_PP = W_PG + (size_t)DM * DM, W_ENDE = W_PP + (size_t)DM * PLE;
static_assert(W_ENDE * 2 <= 58 * MiB, "weights fit");

__device__ __forceinline__ unsigned pk2(float lo, float hi) { f32x2_t v = {lo, hi}; bf16x2_t b = __builtin_convertvector(v, bf16x2_t); return __builtin_bit_cast(unsigned, b); }
__device__ __forceinline__ float bflo(unsigned u) { return __uint_as_float(u << 16); }
__device__ __forceinline__ float bfhi(unsigned u) { return __uint_as_float(u & 0xffff0000u); }
__device__ __forceinline__ float wave_sum(float v) {
#pragma unroll
    for (int o = 1; o < 64; o <<= 1) v += __shfl_xor(v, o);
    return v;
}
__device__ __forceinline__ float max3f(float a, float b, float c) { float r; asm("v_max3_f32 %0, %1, %2, %3" : "=v"(r) : "v"(a), "v"(b), "v"(c)); return r; }
__device__ __forceinline__ float max2f(float a, float b) { float r; asm("v_max_f32_e32 %0, %1, %2" : "=v"(r) : "v"(a), "v"(b)); return r; }
__device__ __forceinline__ float fast_sigmoid(float x) { return __builtin_amdgcn_rcpf(1.f + __expf(-x)); }
__device__ __forceinline__ int lane_id() { int r; asm volatile("v_mbcnt_lo_u32_b32 %0, -1, 0\n\tv_mbcnt_hi_u32_b32 %0, -1, %0" : "=&v"(r)); return r; }
__device__ __forceinline__ int fresh_tid(int wave_s) { return wave_s * 64 + lane_id(); }
__device__ __forceinline__ float uniformf(float v) { return __uint_as_float(__builtin_amdgcn_readfirstlane(__float_as_uint(v))); }
__device__ __forceinline__ void atomic_addf(float* p, float v) { __hip_atomic_fetch_add(p, v, __ATOMIC_RELAXED, __HIP_MEMORY_SCOPE_AGENT); }

__device__ __forceinline__ float row_ssq(const float* part, int pitch, int n4, int row, int fq) {
    f32x4 v = (f32x4){0.f, 0.f, 0.f, 0.f};
    if (fq < n4) v = *(const f32x4*)(part + (size_t)row * pitch + 4 * fq);
    float s = (v[0] + v[1]) + (v[2] + v[3]);
    s += __shfl_xor(s, 16); s += __shfl_xor(s, 32);
    return s;
}
namespace pg8 {
constexpr int BM = 256, BK = 64, HALF = 128, HTB = HALF * BK * 2, STAGE_BYTES = 8 * HTB, NXCD = 8, WGM = 8;
__device__ __forceinline__ int lds_byte(int r, int c) { const int st = (r >> 4) * 2 + (c >> 5), rr = r & 15, cc = c & 31, ob = rr * 64 + cc * 2; return st * 1024 + (ob ^ (((ob >> 9) & 1) << 5)); }
__device__ __forceinline__ void stage_rc(int b, int& R, int& C) { const int st = b / 1024, sb = b % 1024, swz = sb ^ (((sb >> 9) & 1) << 5); R = (st >> 1) * 16 + swz / 64; C = (st & 1) * 32 + (swz % 64) / 2; }
__device__ __forceinline__ int perm32(int rho) { const int n = rho >> 4, i = rho & 15; return 8 * (i >> 2) + 4 * n + (i & 3); }

struct Unit { int pm, pn; };
struct Gemm { const bf16_t* A; const bf16_t* Bt; int M, N, K, lda; };

struct StaticOrder {
    int nM, nN, nwg, G, c;
    __device__ __forceinline__ void init(int M, int N, int G_, int c_) { nM = M / BM; nN = N / BM; nwg = nM * nN; G = G_; c = c_; }
    __device__ __forceinline__ bool next(int i, Unit& u) const {
        const long L = (long)i * G + c; if (L >= nwg) return false;
        int wgid = (int)L; { const int q = nwg / NXCD, r = nwg % NXCD, xcd = wgid % NXCD, off = wgid / NXCD; wgid = (xcd < r ? xcd * (q + 1) : r * (q + 1) + (xcd - r) * q) + off; }
        const int nig = WGM * nN, gid = wgid / nig, fm = gid * WGM, gsz = (nM - fm) < WGM ? (nM - fm) : WGM;
        u.pm = fm + ((wgid % nig) % gsz); u.pn = (wgid % nig) / gsz; return true;
    }
};

template <class Epi>
__device__ __forceinline__ void gemm_phase(LAS unsigned char* lds, int wave_s, const Gemm g, const StaticOrder S, const Epi E) {
    const int tid = fresh_tid(wave_s);
    const int wid = __builtin_amdgcn_readfirstlane(tid >> 6), lane = tid & 63, wr = wid >> 2, wc = wid & 3, fr = lane & 15, fq = lane >> 4;
    const int K = g.K, nt = K / BK, lda = g.lda;
    unsigned voffA[2], voffB[2];
#pragma unroll
    for (int i = 0; i < 2; ++i) { int R, C; stage_rc(tid * 16 + i * 8192, R, C); const int Rb = Epi::PERM ? ((R & ~31) + perm32(R & 31)) : R;
        voffA[i] = (unsigned)(R * lda + C) * 2u; voffB[i] = (unsigned)(Rb * K + C) * 2u; }
    const size_t kstep = (size_t)(BK * 2);
    const size_t hstepA = (size_t)HALF * lda * 2, hstepB = (size_t)HALF * K * 2;
    const size_t tstepA = 2 * hstepA, tstepB = 2 * hstepB;
    const unsigned ldsw = (unsigned)wid * 1024u;
    const int aoff = lds_byte(wr * 64 + fr, fq * 8), boff = lds_byte(wc * 32 + fr, fq * 8);
#define PG8_SA(b, h) (((b) * 2 + (h)) * HTB)
#define PG8_SB(b, h) ((4 + (b) * 2 + (h)) * HTB)
#define PG8_STAGE(bufoff, gbase, voff) do { _Pragma("unroll") for (int _i = 0; _i < 2; ++_i) \
        __builtin_amdgcn_global_load_lds((const unsigned*)((const char*)(gbase) + (voff)[_i]), (LAS unsigned*)(lds + (bufoff) + ldsw + _i * 8192), 16, 0, 0); } while (0)
#define PG8_LDA(dst, b, h) do { _Pragma("unroll") for (int m = 0; m < 4; ++m) _Pragma("unroll") for (int k = 0; k < 2; ++k) dst[m][k] = *(const LAS bf16x8*)(lds + PG8_SA(b, h) + aoff + m * 2048 + k * 1024); } while (0)
#define PG8_LDB(dst, b, h) do { _Pragma("unroll") for (int n = 0; n < 2; ++n) _Pragma("unroll") for (int k = 0; k < 2; ++k) dst[n][k] = *(const LAS bf16x8*)(lds + PG8_SB(b, h) + boff + n * 2048 + k * 1024); } while (0)
#define PG8_MMA(ai, bj, At, Bt) do { __builtin_amdgcn_s_setprio(1); _Pragma("unroll") for (int m = 0; m < 4; ++m) _Pragma("unroll") for (int n = 0; n < 2; ++n) _Pragma("unroll") for (int k = 0; k < 2; ++k) \
        acc[ai][bj][m][n] = __builtin_amdgcn_mfma_f32_16x16x32_bf16(Bt[n][k], At[m][k], acc[ai][bj][m][n], 0, 0, 0); __builtin_amdgcn_s_setprio(0); } while (0)
#define PG8_WAIT_V(n) asm volatile("s_waitcnt vmcnt(" #n ")" ::: "memory")
#define PG8_WAIT_L(n) asm volatile("s_waitcnt lgkmcnt(" #n ")" ::: "memory")
#define PG8_BAR __builtin_amdgcn_s_barrier()
#define PG8_SCHED __builtin_amdgcn_sched_barrier(0)
    Unit cur, nxt; int ui = 0;
    if (!S.next(0, cur)) return;
    f32x4 acc[2][2][4][2];
#pragma unroll
    for (int a = 0; a < 2; ++a)
#pragma unroll
        for (int b = 0; b < 2; ++b)
#pragma unroll
            for (int m = 0; m < 4; ++m)
#pragma unroll
                for (int n = 0; n < 2; ++n) acc[a][b][m][n] = (f32x4){0.f, 0.f, 0.f, 0.f};
    bf16x8 At[4][2], B0[2][2], B1[2][2];
    const char* cA = (const char*)g.A + (size_t)cur.pm * tstepA; const char* cB = (const char*)g.Bt + (size_t)cur.pn * tstepB;
    PG8_STAGE(PG8_SB(0, 0), cB, voffB); PG8_STAGE(PG8_SB(0, 1), cB + hstepB, voffB); PG8_STAGE(PG8_SA(0, 0), cA, voffA); PG8_STAGE(PG8_SA(0, 1), cA + hstepA, voffA);
    if (wr == 1) PG8_BAR;
    PG8_WAIT_V(2); PG8_BAR;
    PG8_STAGE(PG8_SB(1, 0), cB + kstep, voffB); PG8_STAGE(PG8_SA(1, 0), cA + kstep, voffA); PG8_STAGE(PG8_SB(1, 1), cB + hstepB + kstep, voffB);
    PG8_WAIT_V(6); PG8_BAR;
    for (;;) {
        const bool has_next = S.next(ui + 1, nxt);
        const char* nA = has_next ? (const char*)g.A + (size_t)nxt.pm * tstepA : cA; const char* nB = has_next ? (const char*)g.Bt + (size_t)nxt.pn * tstepB : cB;
        for (int t = 0; t < nt; t += 2) {
            const bool last = (t == nt - 2);
            const char* a1 = cA + (size_t)(t + 1) * kstep;
            const char* a2 = last ? nA : cA + (size_t)(t + 2) * kstep; const char* b2 = last ? nB : cB + (size_t)(t + 2) * kstep;
            const char* a3 = a2 + kstep; const char* b3 = b2 + kstep;
            PG8_LDB(B0, 0, 0); PG8_LDB(B1, 0, 1); PG8_SCHED; PG8_LDA(At, 0, 0); PG8_STAGE(PG8_SA(1, 1), a1 + hstepA, voffA);
            PG8_WAIT_V(8); PG8_WAIT_L(0); PG8_BAR; PG8_MMA(0, 0, At, B0); PG8_MMA(0, 1, At, B1); PG8_BAR; PG8_SCHED;
            PG8_LDA(At, 0, 1); PG8_STAGE(PG8_SB(0, 0), b2, voffB); PG8_STAGE(PG8_SB(0, 1), b2 + hstepB, voffB); PG8_STAGE(PG8_SA(0, 0), a2, voffA);
            PG8_WAIT_V(8); PG8_WAIT_L(0); PG8_BAR; PG8_MMA(1, 0, At, B0); PG8_MMA(1, 1, At, B1); PG8_BAR; PG8_SCHED;
            PG8_LDB(B0, 1, 0); PG8_LDB(B1, 1, 1); PG8_SCHED; PG8_LDA(At, 1, 0); PG8_STAGE(PG8_SA(0, 1), a2 + hstepA, voffA);
            PG8_WAIT_V(8); PG8_WAIT_L(0); PG8_BAR; PG8_MMA(0, 0, At, B0); PG8_MMA(0, 1, At, B1); PG8_BAR; PG8_SCHED;
            PG8_LDA(At, 1, 1); PG8_STAGE(PG8_SB(1, 0), b3, voffB); PG8_STAGE(PG8_SB(1, 1), b3 + hstepB, voffB); PG8_STAGE(PG8_SA(1, 0), a3, voffA);
            PG8_WAIT_V(8); PG8_WAIT_L(0); PG8_BAR; PG8_MMA(1, 0, At, B0); PG8_MMA(1, 1, At, B1); PG8_BAR; PG8_SCHED;
        }
        if (wr == 0) PG8_BAR;
        E(acc, cur, wr, wc, fr, fq);
        if (!has_next) break;
#pragma unroll
        for (int a = 0; a < 2; ++a)
#pragma unroll
            for (int b = 0; b < 2; ++b)
#pragma unroll
                for (int m = 0; m < 4; ++m)
#pragma unroll
                    for (int n = 0; n < 2; ++n) acc[a][b][m][n] = (f32x4){0.f, 0.f, 0.f, 0.f};
        cur = nxt; cA = nA; cB = nB; ++ui;
        if (wr == 1) PG8_BAR;
    }
    PG8_WAIT_V(0);
    PG8_BAR;
#undef PG8_SA
#undef PG8_SB
#undef PG8_STAGE
#undef PG8_LDA
#undef PG8_LDB
#undef PG8_MMA
#undef PG8_WAIT_V
#undef PG8_WAIT_L
#undef PG8_BAR
#undef PG8_SCHED
}

struct EpiSwiglu {
    static constexpr bool PERM = true;
    bf16_t* O; const float* ssq;
    __device__ __forceinline__ void operator()(const f32x4 (&acc)[2][2][4][2], const Unit& u, int wr, int wc, int fr, int fq) const {
        const int row0 = u.pm * BM + wr * 64 + fr, col0 = u.pn * 128 + wc * 32 + 8 * fq;
#pragma unroll
        for (int ai = 0; ai < 2; ++ai)
#pragma unroll
            for (int m = 0; m < 4; ++m) {
                const int row = row0 + ai * HALF + m * 16;
                const float rs = rsqrtf(row_ssq(ssq, 16, 4, row, fq) * (1.f / 1024.f) + EPS);
                float r[8];
#pragma unroll
                for (int n = 0; n < 2; ++n)
#pragma unroll
                    for (int e = 0; e < 4; ++e) { const float gv = acc[ai][0][m][n][e] * rs, uv = acc[ai][1][m][n][e] * rs; r[n * 4 + e] = gv * fast_sigmoid(gv) * uv; }
                u32x4 w; w.x = pk2(r[0], r[1]); w.y = pk2(r[2], r[3]); w.z = pk2(r[4], r[5]); w.w = pk2(r[6], r[7]);
                *(u32x4*)(O + (size_t)row * DFF + col0) = w;
            }
    }
};
template <bool GATED>
struct EpiResid {
    static constexpr bool PERM = true;
    const bf16_t* HI; bf16_t* HO; bf16_t* LO; float* ssq_out; const float* ssq_in; const bf16_t* PP; float alpha; float pad_;
    __device__ __forceinline__ void operator()(const f32x4 (&acc)[2][2][4][2], const Unit& u, int wr, int wc, int fr, int fq) const {
        const int row0 = u.pm * BM + wr * 64 + fr, col0 = u.pn * BM + wc * 32 + 8 * fq;
#pragma unroll
        for (int ai = 0; ai < 2; ++ai)
#pragma unroll
            for (int m = 0; m < 4; ++m) {
                const int row = row0 + ai * HALF + m * 16;
                float rs = 0.f; if (GATED) rs = rsqrtf(row_ssq(ssq_in, 16, 4, row, fq) * (1.f / 1024.f) + EPS);
                float sq = 0.f;
#pragma unroll
                for (int bj = 0; bj < 2; ++bj) {
                    const size_t off = (size_t)row * DM + col0 + bj * HALF;
                    const u32x4 hh = *(const u32x4*)(HI + off), ll = *(const u32x4*)(LO + off);
                    float hv[8] = {bflo(hh.x) + bflo(ll.x), bfhi(hh.x) + bfhi(ll.x), bflo(hh.y) + bflo(ll.y), bfhi(hh.y) + bfhi(ll.y),
                                   bflo(hh.z) + bflo(ll.z), bfhi(hh.z) + bfhi(ll.z), bflo(hh.w) + bflo(ll.w), bfhi(hh.w) + bfhi(ll.w)};
                    float av[8] = {acc[ai][bj][m][0][0], acc[ai][bj][m][0][1], acc[ai][bj][m][0][2], acc[ai][bj][m][0][3], acc[ai][bj][m][1][0], acc[ai][bj][m][1][1], acc[ai][bj][m][1][2], acc[ai][bj][m][1][3]};
                    if (GATED) { const u32x4 pp = *(const u32x4*)(PP + off);
                        const float pv[8] = {bflo(pp.x), bfhi(pp.x), bflo(pp.y), bfhi(pp.y), bflo(pp.z), bfhi(pp.z), bflo(pp.w), bfhi(pp.w)};
#pragma unroll
                        for (int e = 0; e < 8; ++e) av[e] = fast_sigmoid(av[e] * rs) * pv[e]; }
                    else {
#pragma unroll
                        for (int e = 0; e < 8; ++e) av[e] *= alpha; }
                    float lo[8];
#pragma unroll
                    for (int e = 0; e < 8; ++e) { hv[e] += av[e]; sq += hv[e] * hv[e]; }
                    u32x4 wh; wh.x = pk2(hv[0], hv[1]); wh.y = pk2(hv[2], hv[3]); wh.z = pk2(hv[4], hv[5]); wh.w = pk2(hv[6], hv[7]);
                    lo[0] = hv[0] - bflo(wh.x); lo[1] = hv[1] - bfhi(wh.x); lo[2] = hv[2] - bflo(wh.y); lo[3] = hv[3] - bfhi(wh.y);
                    lo[4] = hv[4] - bflo(wh.z); lo[5] = hv[5] - bfhi(wh.z); lo[6] = hv[6] - bflo(wh.w); lo[7] = hv[7] - bfhi(wh.w);
                    u32x4 wl; wl.x = pk2(lo[0], lo[1]); wl.y = pk2(lo[2], lo[3]); wl.z = pk2(lo[4], lo[5]); wl.w = pk2(lo[6], lo[7]);
                    *(u32x4*)(HO + off) = wh; *(u32x4*)(LO + off) = wl;
                }
                sq += __shfl_xor(sq, 16); sq += __shfl_xor(sq, 32);
                if (fq == 0) ssq_out[(size_t)row * 16 + 4 * u.pn + wc] = sq;
            }
    }
};
struct EpiGen {
    static constexpr bool PERM = true;
    bf16_t* O; int ldc; const float* ssq_in; float inv_k; int mode; float* ssq_q; float* ssq_kv; const float* rope; int in_pitch; int in_n4;
    __device__ __forceinline__ void operator()(const f32x4 (&acc)[2][2][4][2], const Unit& u, int wr, int wc, int fr, int fq) const {
        const int row0 = u.pm * BM + wr * 64 + fr;
        float rsv[2][4];
#pragma unroll
        for (int ai = 0; ai < 2; ++ai)
#pragma unroll
            for (int m = 0; m < 4; ++m) rsv[ai][m] = ssq_in ? rsqrtf(row_ssq(ssq_in, in_pitch, in_n4, row0 + ai * HALF + m * 16, fq) * inv_k + EPS) : 1.f;
#pragma unroll
        for (int bj = 0; bj < 2; ++bj) {
            const int c0 = u.pn * BM + bj * HALF + wc * 32;
            float scale = 1.f; bool sig = false, rp = false, st = true; float* sq = nullptr; int sqp = 0;
            if (mode == 1) { const int slab = c0 >> 7;
                if (slab < 3) { sq = ssq_q + 4 * slab + wc; sqp = 16; } else if (slab < 5) { sq = ssq_kv + 4 * (slab - 3) + wc; sqp = 8; } else if (slab == 5) { rp = (wc == 0); st = (wc == 0); }
                else if (slab < 14) scale = C2_64; else if (slab < 18) {} else if (slab < 26) scale = C2_64; else if (slab < 42) {} else sig = true;
            } else if (mode == 2) { rp = ((c0 % 96) == 64); scale = C2_96; }
            if (!st) continue;
#pragma unroll
            for (int ai = 0; ai < 2; ++ai)
#pragma unroll
                for (int m = 0; m < 4; ++m) {
                    const int row = row0 + ai * HALF + m * 16; const float rs = rsv[ai][m] * scale;
                    f32x4 v0 = acc[ai][bj][m][0] * rs, v1 = acc[ai][bj][m][1] * rs;
                    if (rp) {
                        const int pos = row & (SEQ - 1); const float* rb = rope + pos * 32 + 8 * (fq & 1); const bool hi2 = (fq >> 1) != 0;
                        const f32x4 cs0 = *(const f32x4*)(rb), cs1 = *(const f32x4*)(rb + 4), sn0 = *(const f32x4*)(rb + 16), sn1 = *(const f32x4*)(rb + 20);
#pragma unroll
                        for (int e = 0; e < 4; ++e) { const float q0 = __shfl_xor(v0[e], 32), q1 = __shfl_xor(v1[e], 32);
                            v0[e] = hi2 ? v0[e] * cs0[e] + q0 * sn0[e] : v0[e] * cs0[e] - q0 * sn0[e];
                            v1[e] = hi2 ? v1[e] * cs1[e] + q1 * sn1[e] : v1[e] * cs1[e] - q1 * sn1[e]; } }
                    if (sig) {
#pragma unroll
                        for (int e = 0; e < 4; ++e) { v0[e] = fast_sigmoid(v0[e]); v1[e] = fast_sigmoid(v1[e]); } }
                    if (sq) { float s = (v0[0] * v0[0] + v0[1] * v0[1]) + (v0[2] * v0[2] + v0[3] * v0[3]) + (v1[0] * v1[0] + v1[1] * v1[1]) + (v1[2] * v1[2] + v1[3] * v1[3]);
                        s += __shfl_xor(s, 16); s += __shfl_xor(s, 32); if (fq == 0) sq[(size_t)row * sqp] = s; }
                    u32x4 w; w.x = pk2(v0[0], v0[1]); w.y = pk2(v0[2], v0[3]); w.z = pk2(v1[0], v1[1]); w.w = pk2(v1[2], v1[3]);
                    *(u32x4*)(O + (size_t)row * ldc + c0 + 8 * fq) = w;
                }
        }
    }
};
}

constexpr int ATT_LUT_OFF = 61440;
template <int DQK, int DV, int MODE, bool RES = false>
__device__ __forceinline__ void flash_core(LAS unsigned char* lds, int wave_s, const bf16_t* Qp, int qpitch, const bf16_t* K1, int k1pitch, const bf16_t* K2, int k2pitch,
                                           const bf16_t* Vp, int vpitch, int q0, int kt_lo, int kt_hi, const LAS float* lut, float sink2, f32x16 (&o)[DV / 32], int win_lo = 0) {
    constexpr int CH = DQK / 8, KS = DQK * 2 + 16, KBUF = 64 * KS, VBUF = 64 * DV * 2, VCH = DV / 8;
    constexpr int NKI = (64 * CH + 511) / 512, NVI = (64 * VCH) / 512, NDB = DV / 32;
    static_assert(RES || 2 * KBUF + 2 * VBUF <= ATT_LUT_OFF, "attention LDS");
    LAS unsigned char* Kl = lds; LAS unsigned char* Vl = lds + (RES ? 8 : 2) * KBUF;
    const int tid = fresh_tid(wave_s);
    const int lane = tid & 63, wid = __builtin_amdgcn_readfirstlane(tid >> 6), r32 = lane & 31, h = lane >> 5;
    bf16x8 qf[DQK / 16];
    { const bf16_t* qrow = Qp + (size_t)(32 * wid + r32) * qpitch + 8 * h;
#pragma unroll
      for (int d0 = 0; d0 < DQK / 16; ++d0) qf[d0] = *(const bf16x8*)(qrow + 16 * d0); }
    float mrun = -INFINITY, lrun = 0.f;
#pragma unroll
    for (int db = 0; db < NDB; ++db)
#pragma unroll
        for (int r = 0; r < 16; ++r) o[db][r] = 0.f;
    const int qw0 = q0 + 32 * wid, qpos = qw0 + r32;
    const bf16x8 ones = (bf16x8){(short)0x3F80, (short)0x3F80, (short)0x3F80, (short)0x3F80, (short)0x3F80, (short)0x3F80, (short)0x3F80, (short)0x3F80};
    u32x4 kreg[NKI], vreg[NVI];
    const unsigned char* ksrc[NKI]; unsigned kstep[NKI]; int kdst[NKI]; bool kval[NKI];
#pragma unroll
    for (int i_ = 0; i_ < NKI; ++i_) { const int idx = tid + 512 * i_; const int key = idx / CH, c = idx % CH; kval[i_] = (idx < 64 * CH);
        if (c < 8) { ksrc[i_] = (const unsigned char*)(K1 + (size_t)key * k1pitch + 8 * c); kstep[i_] = (unsigned)(128 * k1pitch); }
        else       { ksrc[i_] = (const unsigned char*)(K2 + (size_t)key * k2pitch + 8 * (c - 8)); kstep[i_] = (unsigned)(128 * k2pitch); }
        if (!kval[i_]) { ksrc[i_] = (const unsigned char*)K1; kstep[i_] = 0u; }
        kdst[i_] = key * KS + 16 * c; }
    const unsigned char* vsrc0; int vdst0;
    { const int key = tid / VCH, c = tid % VCH; vsrc0 = (const unsigned char*)(Vp + (size_t)key * vpitch + 8 * c); vdst0 = (c >> 2) * 4096 + (key >> 3) * 512 + (key & 7) * 64 + (c & 3) * 16; }
    const unsigned vrowoff = (unsigned)((512 / VCH) * vpitch * 2);
    constexpr int VDSTOFF = ((512 / VCH) >> 3) * 512;
    const unsigned vstep = (unsigned)(128 * vpitch);
#define FA_LOADK(kt) do { _Pragma("unroll") for (int i_ = 0; i_ < NKI; ++i_) kreg[i_] = *(const u32x4*)(ksrc[i_] + (size_t)(unsigned)(kt) * kstep[i_]); } while (0)
#define FA_LOADV(kt) do { _Pragma("unroll") for (int i_ = 0; i_ < NVI; ++i_) vreg[i_] = *(const u32x4*)(vsrc0 + (size_t)(unsigned)(kt) * vstep + (size_t)i_ * vrowoff); } while (0)
#define FA_STOREK(buf) do { _Pragma("unroll") for (int i_ = 0; i_ < NKI; ++i_) { if (kval[i_]) *(LAS u32x4*)(Kl + (buf) * KBUF + kdst[i_]) = kreg[i_]; } } while (0)
#define FA_STOREV(buf) do { _Pragma("unroll") for (int i_ = 0; i_ < NVI; ++i_) *(LAS u32x4*)(Vl + (buf) * VBUF + vdst0 + i_ * VDSTOFF) = vreg[i_]; } while (0)
#define FA_QK(P0, P1, kbuf, CI) do { const LAS unsigned char* kb_ = Kl + (kbuf) * KBUF + r32 * KS + 16 * h; \
    _Pragma("unroll") for (int d0 = 0; d0 < DQK / 16; ++d0) { \
        const bf16x8 a0 = *(const LAS bf16x8*)(kb_ + 32 * d0), a1 = *(const LAS bf16x8*)(kb_ + 32 * KS + 32 * d0); \
        if (d0 == 0) { P0 = __builtin_amdgcn_mfma_f32_32x32x16_bf16(a0, qf[0], CI, 0, 0, 0); P1 = __builtin_amdgcn_mfma_f32_32x32x16_bf16(a1, qf[0], CI, 0, 0, 0); } \
        else { P0 = __builtin_amdgcn_mfma_f32_32x32x16_bf16(a0, qf[d0], P0, 0, 0, 0); P1 = __builtin_amdgcn_mfma_f32_32x32x16_bf16(a1, qf[d0], P1, 0, 0, 0); } } } while (0)
#define SBAR() __builtin_amdgcn_sched_barrier(0)
#define FA_CHUNK(c, p0, p1) do { \
    if ((c) < 4) { ma = max3f(ma, p0[4 * (c)], p0[4 * (c) + 1]); mb = max3f(mb, p0[4 * (c) + 2], p0[4 * (c) + 3]); ma = max3f(ma, p1[4 * (c)], p1[4 * (c) + 1]); mb = max3f(mb, p1[4 * (c) + 2], p1[4 * (c) + 3]); } \
    else if ((c) == 4) { float rm = max2f(ma, mb); { auto rr_ = __builtin_amdgcn_permlane32_swap(__float_as_uint(rm), __float_as_uint(rm), false, false); rm = max2f(__uint_as_float(rr_[0]), __uint_as_float(rr_[1])); } \
        if (NEGM) {   \
            const bool need_ = __any(rm > 5.0f || rm < -40.0f); pendf = need_; pend = 0.f; alpha = 1.f; \
            if (need_) { const float dl_ = (rm > 0.f || rm < -40.0f) ? rm : 0.f; _Pragma("unroll") for (int r_ = 0; r_ < 16; ++r_) { p0[r_] -= dl_; p1[r_] -= dl_; } \
                alpha = __builtin_amdgcn_exp2f(-dl_); mrun += dl_; pend = dl_; } } \
        else { rm += ctile;   \
        const bool need_ = __any(rm > mrun + 5.0f); const float mnew = need_ ? max2f(mrun, rm) : mrun; const float muse = (mnew == -INFINITY) ? 0.f : mnew; alpha = __builtin_amdgcn_exp2f(mrun - muse); mrun = mnew; msub = muse - ctile; } } \
    else if ((c) < 9) { _Pragma("unroll") for (int e_ = 0; e_ < 4; ++e_) p0[4 * ((c) - 5) + e_] = NEGM ? __builtin_amdgcn_exp2f(p0[4 * ((c) - 5) + e_]) : __builtin_amdgcn_exp2f(p0[4 * ((c) - 5) + e_] - msub); \
        asm volatile("" : "+v"(p0[4 * ((c) - 5)]), "+v"(p0[4 * ((c) - 5) + 1]), "+v"(p0[4 * ((c) - 5) + 2]), "+v"(p0[4 * ((c) - 5) + 3])); } \
    else { _Pragma("unroll") for (int e_ = 0; e_ < 4; ++e_) p1[4 * ((c) - 9) + e_] = NEGM ? __builtin_amdgcn_exp2f(p1[4 * ((c) - 9) + e_]) : __builtin_amdgcn_exp2f(p1[4 * ((c) - 9) + e_] - msub); \
        asm volatile("" : "+v"(p1[4 * ((c) - 9)]), "+v"(p1[4 * ((c) - 9) + 1]), "+v"(p1[4 * ((c) - 9) + 2]), "+v"(p1[4 * ((c) - 9) + 3])); } } while (0)
#define FA_GAP(g, p0, p1) do { if ((g) + 1 <= 8) FA_CHUNK((g) + 1, p0, p1); SBAR(); } while (0)
#define FA_KFRAG(d) (*(const LAS bf16x8*)(kb_ + 32 * (d))), (*(const LAS bf16x8*)(kb_ + 32 * KS + 32 * (d)))
#define FA_STEP(p0, p1, SN0, SN1, t) do { const int tt_ = (t) - kt_lo; float ctile = 0.f; \
    if (MODE == 2) { const int tlo = 64 * (t); \
        if (tlo + 63 - qw0 <= -128) { if (!NEGM) ctile = lut[0]; } else if (tlo - (qw0 + 31) >= 128) { if (!NEGM) ctile = lut[511]; } \
        else { const LAS float* lq_ = lut + (tlo + 4 * h - qpos + 256); _Pragma("unroll") for (int r = 0; r < 16; ++r) { p0[r] += lq_[(r & 3) + 8 * (r >> 2)]; p1[r] += lq_[(r & 3) + 8 * (r >> 2) + 32]; } } } \
    if (MODE == 1) { const LAS float* lp_ = lut + (64 * (t) + 4 * h - qpos + 320); \
        _Pragma("unroll") for (int r = 0; r < 16; ++r) { p0[r] += lp_[(r & 3) + 8 * (r >> 2)]; p1[r] += lp_[(r & 3) + 8 * (r >> 2) + 32]; } } \
    if (NEGM) { if (pendf) { _Pragma("unroll") for (int r_ = 0; r_ < 16; ++r_) { p0[r_] -= pend; p1[r_] -= pend; } } \
        float cn_ = 0.f; if (MODE == 2) { const int tl1 = 64 * ((t) + 1); if (tl1 + 63 - qw0 <= -128) cn_ = lut[0]; else if (tl1 - (qw0 + 31) >= 128) cn_ = lut[511]; } \
        const float cb_ = cn_ - mrun; if (__any(cb_ != cbs)) { cbs = cb_; _Pragma("unroll") for (int r_ = 0; r_ < 16; ++r_) negc[r_] = cb_; } } \
    SBAR(); \
      \
    float ma = -INFINITY, mb = -INFINITY, alpha = 1.f, msub = 0.f; \
    bf16x8 vfr[4][NDB]; const LAS unsigned char* vbs_ = Vl + (RES ? ((t) - win_lo) : (tt_ & 1)) * VBUF + vlane; \
    { const LAS unsigned char* kb_ = Kl + (RES ? (min((t) + 1, kt_hi - 1) - win_lo) : ((tt_ + 1) & 1)) * KBUF + r32 * KS + 16 * h; \
      bf16x8 kf[DQK / 16][2]; \
      kf[0][0] = *(const LAS bf16x8*)(kb_); kf[0][1] = *(const LAS bf16x8*)(kb_ + 32 * KS); kf[1][0] = *(const LAS bf16x8*)(kb_ + 32); kf[1][1] = *(const LAS bf16x8*)(kb_ + 32 * KS + 32); \
      if (KD > 2) { kf[2][0] = *(const LAS bf16x8*)(kb_ + 64); kf[2][1] = *(const LAS bf16x8*)(kb_ + 32 * KS + 64); } \
      if (!RES) { FA_LOADK(min((t) + 2, kt_hi - 1)); FA_LOADV(min((t) + 1, kt_hi - 1)); } \
      FA_CHUNK(0, p0, p1); SBAR(); \
      _Pragma("unroll") for (int d0 = 0; d0 < DQK / 16; ++d0) { \
        if (d0 + KD < DQK / 16) { kf[d0 + KD][0] = *(const LAS bf16x8*)(kb_ + 32 * (d0 + KD)); kf[d0 + KD][1] = *(const LAS bf16x8*)(kb_ + 32 * KS + 32 * (d0 + KD)); } \
        if (VPRE && (d0 == 1 || d0 == 2)) { _Pragma("unroll") for (int db = 0; db < NDB; ++db) { const LAS unsigned char* vp = vbs_ + db * 4096 + (d0 - 1) * 1024; \
            const v4i16_t lo = __builtin_amdgcn_ds_read_tr16_b64_v4i16((LAS v4i16_t*)vp); const v4i16_t hi = __builtin_amdgcn_ds_read_tr16_b64_v4i16((LAS v4i16_t*)(vp + 512)); \
            vfr[d0 - 1][db] = (bf16x8){lo[0], lo[1], lo[2], lo[3], hi[0], hi[1], hi[2], hi[3]}; } } \
        if (d0 == 0) SN0 = __builtin_amdgcn_mfma_f32_32x32x16_bf16(kf[0][0], qf[0], NEGM ? negc : zero16, 0, 0, 0); else SN0 = __builtin_amdgcn_mfma_f32_32x32x16_bf16(kf[d0][0], qf[d0], SN0, 0, 0, 0); \
        FA_GAP(2 * d0, p0, p1); \
        if (d0 == 0) SN1 = __builtin_amdgcn_mfma_f32_32x32x16_bf16(kf[0][1], qf[0], NEGM ? negc : zero16, 0, 0, 0); else SN1 = __builtin_amdgcn_mfma_f32_32x32x16_bf16(kf[d0][1], qf[d0], SN1, 0, 0, 0); \
        FA_GAP(2 * d0 + 1, p0, p1); } } \
    if (!__all(alpha == 1.0f)) { _Pragma("unroll") for (int db = 0; db < NDB; ++db) _Pragma("unroll") for (int r = 0; r < 16; ++r) o[db][r] *= alpha; } \
    SBAR(); \
      \
    { f32x16 lacc; u32x4 pw, pwn; \
      pw.x = pk2(p0[0], p0[1]); pw.y = pk2(p0[2], p0[3]); pw.z = pk2(p0[4], p0[5]); pw.w = pk2(p0[6], p0[7]); pwn = pw; \
      if (!VPRE) { _Pragma("unroll") for (int s_ = 0; s_ < 2; ++s_) _Pragma("unroll") for (int db = 0; db < NDB; ++db) { const LAS unsigned char* vp = vbs_ + db * 4096 + s_ * 1024; \
            const v4i16_t lo = __builtin_amdgcn_ds_read_tr16_b64_v4i16((LAS v4i16_t*)vp); const v4i16_t hi = __builtin_amdgcn_ds_read_tr16_b64_v4i16((LAS v4i16_t*)(vp + 512)); \
            vfr[s_][db] = (bf16x8){lo[0], lo[1], lo[2], lo[3], hi[0], hi[1], hi[2], hi[3]}; } } \
      SBAR(); \
      _Pragma("unroll") for (int s4 = 0; s4 < 4; ++s4) { \
        const bf16x8 pb = __builtin_bit_cast(bf16x8, pw); \
        lacc = __builtin_amdgcn_mfma_f32_32x32x16_bf16(ones, pb, (s4 == 0) ? zero16 : lacc, 0, 0, 0); \
        if (s4 == 0) { pwn.x = pk2(p0[8], p0[9]); pwn.y = pk2(p0[10], p0[11]); pwn.z = pk2(p0[12], p0[13]); pwn.w = pk2(p0[14], p0[15]); } \
        if (s4 == 1) { pwn.x = pk2(p1[0], p1[1]); pwn.y = pk2(p1[2], p1[3]); pwn.z = pk2(p1[4], p1[5]); pwn.w = pk2(p1[6], p1[7]); } \
        if (s4 == 2) { pwn.x = pk2(p1[8], p1[9]); pwn.y = pk2(p1[10], p1[11]); pwn.z = pk2(p1[12], p1[13]); pwn.w = pk2(p1[14], p1[15]); } \
        SBAR(); \
        _Pragma("unroll") for (int db = 0; db < NDB; ++db) { \
            o[db] = __builtin_amdgcn_mfma_f32_32x32x16_bf16(vfr[s4][db], pb, o[db], 0, 0, 0); \
            if (s4 < 2) { const LAS unsigned char* vp = vbs_ + db * 4096 + (s4 + 2) * 1024; \
                const v4i16_t lo = __builtin_amdgcn_ds_read_tr16_b64_v4i16((LAS v4i16_t*)vp); const v4i16_t hi = __builtin_amdgcn_ds_read_tr16_b64_v4i16((LAS v4i16_t*)(vp + 512)); \
                vfr[s4 + 2][db] = (bf16x8){lo[0], lo[1], lo[2], lo[3], hi[0], hi[1], hi[2], hi[3]}; } \
            if (s4 < 2 && db >= NDB - 2) FA_CHUNK(9 + 2 * s4 + (db - (NDB - 2)), p0, p1); \
            SBAR(); } \
        pw = pwn; } \
      lrun = lrun * alpha + lacc[0]; } \
    if (!RES) { FA_STOREK(tt_ & 1); FA_STOREV((tt_ + 1) & 1); __syncthreads(); } } while (0)
    const int vlane = (4 * h + ((lane & 15) >> 2)) * 64 + ((lane >> 4) & 1) * 32 + (lane & 3) * 8;
    f32x16 zero16;
#pragma unroll
    for (int r = 0; r < 16; ++r) zero16[r] = 0.f;
    f32x16 pA0 = zero16, pA1 = zero16, pB0 = zero16, pB1 = zero16;
    constexpr bool VPRE = (DV <= 64); constexpr int KD = (DV <= 64) ? 3 : 2;
    constexpr bool NEGM = (MODE != 1);
    f32x16 negc = zero16; float cbs = 0.f, pend = 0.f; bool pendf = false;
    if (NEGM) mrun = 0.f;
    if (!RES) {
        FA_LOADK(kt_lo); FA_LOADV(kt_lo); FA_STOREK(0); FA_STOREV(0);
        FA_LOADK(kt_lo + 1);
        __syncthreads();
        if (NEGM) { if (MODE == 2) {     const int tl0 = 64 * kt_lo; float c0_ = 0.f; if (tl0 + 63 - qw0 <= -128) c0_ = lut[0]; else if (tl0 - (qw0 + 31) >= 128) c0_ = lut[511]; cbs = c0_;
#pragma unroll
        for (int r_ = 0; r_ < 16; ++r_) negc[r_] = c0_; } }
        FA_QK(pA0, pA1, 0, negc);
        FA_STOREK(1);
        __syncthreads();
    } else {
        FA_QK(pA0, pA1, kt_lo - win_lo, zero16);
    }
    for (int kt = kt_lo; kt < kt_hi; kt += 2) {
        FA_STEP(pA0, pA1, pB0, pB1, kt);
        FA_STEP(pB0, pB1, pA0, pA1, kt + 1);
    }
#undef SBAR
#undef FA_CHUNK
#undef FA_KFRAG
#undef FA_GAP
#undef FA_LOADK
#undef FA_LOADV
#undef FA_STOREK
#undef FA_STOREV
#undef FA_QK
#undef FA_STEP
    float lt = lrun;
    if (MODE == 1) lt += __builtin_amdgcn_exp2f(sink2 - mrun);
    const float inv = 1.f / lt;
#pragma unroll
    for (int db = 0; db < NDB; ++db)
#pragma unroll
        for (int r = 0; r < 16; ++r) o[db][r] *= inv;
}

template <int DV, bool ACCUM, bool EXTRA = false>
__device__ __forceinline__ void attn_store(const f32x16 (&o)[DV / 32], const bf16_t* gate_row, bf16_t* merged_row, int h, const bf16_t* extra_row = nullptr) {
#pragma unroll
    for (int db = 0; db < DV / 32; ++db)
#pragma unroll
        for (int rg = 0; rg < 4; ++rg) {
            const int d = 32 * db + 8 * rg + 4 * h;
            const u32x2 g = *(const u32x2*)(gate_row + d);
            float v0 = o[db][4 * rg + 0] * bflo(g.x), v1 = o[db][4 * rg + 1] * bfhi(g.x), v2 = o[db][4 * rg + 2] * bflo(g.y), v3 = o[db][4 * rg + 3] * bfhi(g.y);
            if (ACCUM) { const u32x2 mm = *(const u32x2*)(merged_row + d); v0 += bflo(mm.x); v1 += bfhi(mm.x); v2 += bflo(mm.y); v3 += bfhi(mm.y); }
            if (EXTRA) { const u32x2 ee = *(const u32x2*)(extra_row + d); v0 += bflo(ee.x); v1 += bfhi(ee.x); v2 += bflo(ee.y); v3 += bfhi(ee.y); }
            u32x2 w; w.x = pk2(v0, v1); w.y = pk2(v2, v3);
            *(u32x2*)(merged_row + d) = w;
            if (rg == 3) __builtin_amdgcn_sched_barrier(0);
        }
}

__device__ __forceinline__ void build_lut(LAS float* lut, const float* rel_table, int col, int wave_s) {
    const int tid = fresh_tid(wave_s);
    if (tid < 257) {
        const int rel = tid - 128, n = rel < 0 ? -rel : rel, base = rel > 0 ? 16 : 0; int bkt;
        if (n < 8) bkt = n; else { const unsigned t = (unsigned)(n * n) >> 6; const int k = 31 - __clz((int)t); bkt = min(8 + k, 15); }
        lut[tid] = rel_table[(base + bkt) * 24 + col] * LOG2E;
    }
}

__device__ __forceinline__ void build_lut_dense(LAS float* lut, const float* rel_table, int col, int wave_s) {
    const int tid = fresh_tid(wave_s);
    { const int rel = tid - 256, n = rel < 0 ? -rel : rel, base = rel > 0 ? 16 : 0; int bkt;
      if (n < 8) bkt = n; else { const unsigned t = (unsigned)(n * n) >> 6; const int k = 31 - __clz((int)t); bkt = min(8 + k, 15); }
      lut[tid] = rel_table[(base + bkt) * 24 + col] * LOG2E; }
}

__device__ __forceinline__ void build_lut_pad(LAS float* lut, const float* rel_table, int col, int wave_s) {
    const int tid = fresh_tid(wave_s);
    for (int i = tid; i < 640; i += 512) {
        const int rel = i - 320, n = rel < 0 ? -rel : rel, base = rel > 0 ? 16 : 0; int bkt;
        if (n < 8) bkt = n; else { const unsigned t = (unsigned)(n * n) >> 6; const int k = 31 - __clz((int)t); bkt = min(8 + k, 15); }
        lut[i] = (n <= 128) ? rel_table[(base + bkt) * 24 + col] * LOG2E : -INFINITY;
    }
}

typedef unsigned gu32_t;
#define RLX_AGENT __ATOMIC_RELAXED, __HIP_MEMORY_SCOPE_AGENT
#define XB_TMO      128
#define XB_XCNT(j)  (256  + 64 * (j))
#define XB_XSUB(j)  (1280 + 64 * (j))
#define XB_XGEN(j)  (2304 + 64 * (j))
#define XB_TOP      3328
#define XB_TOPGEN   3392
#define XCD_BAR_WORDS 3456
#define XB_SPIN_CAP (1u << 18)

__device__ __forceinline__ unsigned xb_ld(unsigned* p)              { return __hip_atomic_load(p, __ATOMIC_RELAXED, __HIP_MEMORY_SCOPE_AGENT); }
__device__ __forceinline__ unsigned xb_add(unsigned* p, unsigned v) { return __hip_atomic_fetch_add(p, v, __ATOMIC_RELAXED, __HIP_MEMORY_SCOPE_AGENT); }
__device__ __forceinline__ unsigned xb_xcc_id() { return (unsigned)__builtin_amdgcn_s_getreg((3 << 11) | 20) & 0xFu; }
#define XB_SPIN(cond, bar) do { unsigned _sp = 0; while (cond) { __builtin_amdgcn_s_sleep(1); \
    if ((++_sp & 255u) == 0u) { if (xb_ld(&(bar)[XB_TMO])) break; if (_sp > XB_SPIN_CAP) { atomicAdd(&(bar)[XB_TMO], 1u); break; } } } } while (0)

struct XcdBarrier {
    unsigned* bar; unsigned x;
    volatile LAS unsigned* st;
};

__device__ __forceinline__ XcdBarrier xcd_barrier_post(unsigned* bar, volatile LAS unsigned* st) {
    XcdBarrier b; b.bar = bar; b.x = xb_xcc_id(); b.st = st;
    if (threadIdx.x == 0) (void)xb_add(&bar[XB_XCNT(b.x)], 1u);
    return b;
}
__device__ __forceinline__ void xcd_barrier_complete(unsigned* bar, unsigned x, unsigned& nloc, unsigned& nx) {
    const unsigned G = gridDim.x * gridDim.y * gridDim.z;
    unsigned sum, cnt, mine, sp = 0u;
    for (;;) {
        sum = 0u; cnt = 0u; mine = 0u;
#pragma unroll
        for (unsigned j = 0; j < 16; ++j) { const unsigned c = xb_ld(&bar[XB_XCNT(j)]); sum += c; cnt += (c > 0u) ? 1u : 0u; mine = (j == x) ? c : mine; }
        if (sum == G) break;
        __builtin_amdgcn_s_sleep(1);
        if ((++sp & 255u) == 0u) { if (xb_ld(&bar[XB_TMO])) break; if (sp > XB_SPIN_CAP) { atomicAdd(&bar[XB_TMO], 1u); break; } }
    }
    nloc = mine > 0u ? mine : 1u; nx = cnt > 0u ? cnt : 1u;
}

__device__ __forceinline__ void xcd_barrier(const XcdBarrier& b) {
    asm volatile("s_waitcnt vmcnt(0)" ::: "memory");
    __syncthreads();
    if (threadIdx.x == 0) {
        unsigned* bar = b.bar;
        __builtin_amdgcn_s_waitcnt(0);
        unsigned nloc = b.st[0], nx = b.st[1];
        if (nloc == 0u) { xcd_barrier_complete(bar, b.x, nloc, nx); b.st[0] = nloc; b.st[1] = nx; }
        const unsigned old = xb_add(&bar[XB_XSUB(b.x)], 1u);
        const unsigned gen = old / nloc;
        if (old + 1u == (gen + 1u) * nloc) {
            __builtin_amdgcn_fence(__ATOMIC_RELEASE, "agent");
            asm volatile("s_waitcnt vmcnt(0)" ::: "memory");
            const unsigned og = xb_add(&bar[XB_TOP], 1u);
            const unsigned tg = og / nx;
            if (og + 1u == (tg + 1u) * nx) xb_add(&bar[XB_TOPGEN], 1u);
            else XB_SPIN(xb_ld(&bar[XB_TOPGEN]) == tg, bar);
            __builtin_amdgcn_fence(__ATOMIC_ACQUIRE, "agent");
            xb_add(&bar[XB_XGEN(b.x)], 1u);
            asm volatile("s_waitcnt vmcnt(0)" ::: "memory");
        } else {
            XB_SPIN(xb_ld(&bar[XB_XGEN(b.x)]) == gen, bar);
            __builtin_amdgcn_fence(__ATOMIC_ACQUIRE, "agent");
            asm volatile("s_waitcnt vmcnt(0)" ::: "memory");
        }
    }
    __syncthreads();
}


struct Args { const float* in[28]; float* out; unsigned char* ws; };

__device__ __forceinline__ void conv_item(const float* W, int K, int N, const float* gain, bf16_t* WT, int dst_row0, LAS float* scr, int kb, int n0, int lane) {
    const int k0 = 64 * kb;
    float v[32];
    const float* wp = W + (size_t)(k0 + (lane >> 5)) * N + n0 + (lane & 31);
#pragma unroll
    for (int i = 0; i < 32; ++i) v[i] = wp[(size_t)(2 * i) * N];
    if (gain) {
#pragma unroll
        for (int i = 0; i < 32; ++i) v[i] *= gain[k0 + 2 * i + (lane >> 5)];
    }
#pragma unroll
    for (int i = 0; i < 32; ++i) scr[(2 * i + (lane >> 5)) * 33 + (lane & 31)] = v[i];
    asm volatile("s_waitcnt lgkmcnt(0)" ::: "memory");
    const int c = lane & 7;
#pragma unroll
    for (int j = 0; j < 4; ++j) { const int n = (lane >> 3) + 8 * j; const LAS float* s = scr + (8 * c) * 33 + n;
        u32x4 o; o.x = pk2(s[0 * 33], s[1 * 33]); o.y = pk2(s[2 * 33], s[3 * 33]); o.z = pk2(s[4 * 33], s[5 * 33]); o.w = pk2(s[6 * 33], s[7 * 33]);
        *(u32x4*)(WT + (size_t)(dst_row0 + n) * K + k0 + 8 * c) = o; }
    asm volatile("s_waitcnt lgkmcnt(0)" ::: "memory");
}

__global__ void __launch_bounds__(512) fwd_megakernel(Args a) {
    extern __shared__ __attribute__((aligned(16))) unsigned char lds_raw[];
    LAS unsigned char* lds = (LAS unsigned char*)lds_raw;
    cg::grid_group grid = cg::this_grid();
#define GSYNC() do { asm volatile("s_waitcnt vmcnt(0) lgkmcnt(0)" ::: "memory"); __syncthreads(); grid.sync(); } while (0)
    { volatile LAS unsigned* st0 = (volatile LAS unsigned*)(lds + 147456 - 64); if (threadIdx.x < 16) st0[threadIdx.x] = 0u; }
    __syncthreads();
    const XcdBarrier xbar = xcd_barrier_post((unsigned*)(a.ws + WS_BAR), (volatile LAS unsigned*)(lds + 147456 - 64));
#define XSYNC() do { asm volatile("s_waitcnt vmcnt(0) lgkmcnt(0)" ::: "memory"); xcd_barrier(xbar); } while (0)
    const int wave_s = __builtin_amdgcn_readfirstlane(threadIdx.x >> 6);
    const int G = gridDim.x, bx = blockIdx.x, vcu = (G % 8 == 0) ? (bx % 8) * (G / 8) + bx / 8 : bx;
    const int NGW = G * 8;
#define FRESH_IDS const int tid = fresh_tid(wave_s); const int lane = tid & 63, wave = wave_s, gw = vcu * 8 + wave; (void)lane; (void)gw; (void)tid;
    unsigned char* ws = a.ws;
    float* PH0 = (float*)(ws + WS_PH0); float* PH1 = (float*)(ws + WS_PH1); float* PH2 = (float*)(ws + WS_PH2); float* PH3 = (float*)(ws + WS_PH3);
    float* PQ = (float*)(ws + WS_PQ); float* PKV = (float*)(ws + WS_PKV);
    float* rope = (float*)(ws + WS_ROPE);
    bf16_t* Wb = (bf16_t*)(ws + WS_W);
    bf16_t* PB = (bf16_t*)(ws + WS_PB);
    bf16_t* HB = (bf16_t*)(ws + WS_HB);
    bf16_t* ACT = (bf16_t*)(ws + WS_ACT);
    bf16_t* QA = (bf16_t*)(ws + WS_QA);
    bf16_t* KVA = (bf16_t*)(ws + WS_KVA);
    bf16_t* HID = (bf16_t*)(ws + WS_HID);
    bf16_t* PPJ = (bf16_t*)(ws + WS_PPJ);
    float* Hf = a.out;
    bf16_t* LOP = (bf16_t*)((unsigned char*)a.out + (size_t)128 * MiB);
    const float* rel_table = a.in[18];

    {
        FRESH_IDS
        const float* x = a.in[0];
        for (int m = gw; m < MTOK; m += NGW) {
            const f32x4* xr = (const f32x4*)(x + (size_t)m * DM) + lane; u32x2* l8 = (u32x2*)(LOP + (size_t)m * DM) + lane;
            u32x2* o8 = (u32x2*)(HB + (size_t)m * DM) + lane; float s = 0.f;
#pragma unroll
            for (int j = 0; j < 4; ++j) { const f32x4 v = xr[64 * j]; s += (v[0] * v[0] + v[1] * v[1]) + (v[2] * v[2] + v[3] * v[3]); u32x2 w; w.x = pk2(v[0], v[1]); w.y = pk2(v[2], v[3]); o8[64 * j] = w;
                u32x2 wl; wl.x = pk2(v[0] - bflo(w.x), v[1] - bfhi(w.x)); wl.y = pk2(v[2] - bflo(w.y), v[3] - bfhi(w.y)); l8[64 * j] = wl; }
            s = wave_sum(s); if (lane < 16) PH0[(size_t)m * 16 + lane] = (lane == 0) ? s : 0.f;
        }
        const int gt = gw * 64 + lane, NGT = NGW * 64;
        { u32x4* z = (u32x4*)(Wb + W_IN + (size_t)672 * DM); for (int i = gt; i < 96 * DM / 8; i += NGT) z[i] = (u32x4){0u, 0u, 0u, 0u}; }
        for (int i = gt; i < SEQ * 16; i += NGT) { const int pos = i >> 4, k = i & 15; const float inv = exp2f(-(float)k * 0.8304820237218406f); const float ang = (float)pos * inv;
            float r = ang * 0.15915494309189535f; r = r - floorf(r); rope[pos * 32 + k] = __builtin_amdgcn_cosf(r); rope[pos * 32 + 16 + k] = __builtin_amdgcn_sinf(r); }
    }

#pragma nounroll
    for (int L = 0; L < DEPTH; ++L) {
        {
            FRESH_IDS
            LAS float* scr = (LAS float*)(lds + wave * 16384);
            const float* g_ffn1 = a.in[2] + (size_t)L * DM; const float* g_mix = a.in[6] + (size_t)L * DM; const float* g_q = a.in[8] + (size_t)L * 384; const float* g_kv = a.in[10] + (size_t)L * 256;
            const float* g_ffn2 = a.in[20] + (size_t)L * DM; const float* g_ple = a.in[24] + (size_t)L * DM;
            const float* w_g1 = a.in[3] + (size_t)L * DM * DFF; const float* w_u1 = a.in[4] + (size_t)L * DM * DFF; const float* w_d1 = a.in[5] + (size_t)L * DFF * DM;
            const float* w_in = a.in[7] + (size_t)L * DM * INW; const float* w_uq = a.in[9] + (size_t)L * 384 * QAW; const float* w_ukv = a.in[11] + (size_t)L * 256 * KVAW;
            const float* w_out = a.in[19] + (size_t)L * DM * DM;
            const float* w_g2 = a.in[21] + (size_t)L * DM * DFF; const float* w_u2 = a.in[22] + (size_t)L * DM * DFF; const float* w_d2 = a.in[23] + (size_t)L * DFF * DM;
            const float* w_pg = a.in[25] + (size_t)L * DM * DM; const float* w_pp = a.in[26] + (size_t)L * PLE * DM;
            constexpr int I_G = 16 * 88, I_D = 44 * 32, I_IN = 16 * 261, I_UQ = 6 * 48, I_UKV = 4 * 64, I_SQ = 16 * 32, I_PP = 4 * 32;
            constexpr int NITEMS = 4 * I_G + 2 * I_D + I_IN + I_UQ + I_UKV + 2 * I_SQ + I_PP;
#define CONV_MAT(CNT, W_, K_, N_, G_, DST_, MAPEXPR) if (r < (CNT)) { const int nblk = (N_) / 32, kb = r / nblk, n0 = (r % nblk) * 32; conv_item(W_, K_, N_, G_, DST_, (MAPEXPR), scr, kb, n0, lane); continue; } r -= (CNT);
            for (int it = gw; it < NITEMS; it += NGW) {
                int r = it;
                CONV_MAT(I_G, w_g1, DM, DFF, g_ffn1, Wb + W_GU1, (n0 >> 7) * 256 + (n0 & 127))
                CONV_MAT(I_G, w_u1, DM, DFF, g_ffn1, Wb + W_GU1, (n0 >> 7) * 256 + 128 + (n0 & 127))
                CONV_MAT(I_D, w_d1, DFF, DM, (const float*)nullptr, Wb + W_D1, n0)
                CONV_MAT(I_IN, w_in, DM, INW, g_mix, Wb + W_IN, (n0 < 672 ? n0 : n0 + 96))
                CONV_MAT(I_UQ, w_uq, 384, QAW, g_q, Wb + W_UQ, n0)
                CONV_MAT(I_UKV, w_ukv, 256, KVAW, g_kv, Wb + W_UKV, n0)
                CONV_MAT(I_SQ, w_out, DM, DM, (const float*)nullptr, Wb + W_OUT, n0)
                CONV_MAT(I_G, w_g2, DM, DFF, g_ffn2, Wb + W_GU2, (n0 >> 7) * 256 + (n0 & 127))
                CONV_MAT(I_G, w_u2, DM, DFF, g_ffn2, Wb + W_GU2, (n0 >> 7) * 256 + 128 + (n0 & 127))
                CONV_MAT(I_D, w_d2, DFF, DM, (const float*)nullptr, Wb + W_D2, n0)
                CONV_MAT(I_SQ, w_pg, DM, DM, g_ple, Wb + W_PG, n0)
                CONV_MAT(I_PP, w_pp, PLE, DM, (const float*)nullptr, Wb + W_PP, n0)
            }
#undef CONV_MAT
            const int gt = gw * 64 + lane, NGT = NGW * 64;
            { const f32x4* ps = (const f32x4*)(a.in[1] + (size_t)L * MTOK * PLE); u32x4* pd = (u32x4*)PB;
              for (int i = gt; i < MTOK * PLE / 8; i += NGT) { const f32x4 v0 = ps[2 * i], v1 = ps[2 * i + 1]; u32x4 w; w.x = pk2(v0[0], v0[1]); w.y = pk2(v0[2], v0[3]); w.z = pk2(v1[0], v1[1]); w.w = pk2(v1[2], v1[3]); pd[i] = w; } }
        }
        GSYNC();

        float* ssq0 = PH0; float* ssq1 = PH1; float* ssq2 = PH2; float* ssq3 = PH3; float* ssq4 = PH0;

        { pg8::Gemm g{(L == 0) ? HB : (const bf16_t*)QA, Wb + W_GU1, MTOK, 2 * DFF, DM, DM}; pg8::StaticOrder S; S.init(MTOK, 2 * DFF, G, bx);
          pg8::EpiSwiglu E{HID, ssq0}; pg8::gemm_phase(lds, wave_s, g, S, E); }
        XSYNC();
        { pg8::Gemm g{HID, Wb + W_D1, MTOK, DM, DFF, DFF}; pg8::StaticOrder S; S.init(MTOK, DM, G, bx);
          pg8::EpiResid<false> E{(L == 0) ? HB : (const bf16_t*)QA, HB, LOP, ssq1, nullptr, nullptr, 0.5f, 0.f}; pg8::gemm_phase(lds, wave_s, g, S, E); }
        XSYNC();

#pragma nounroll
        for (int ck = 0; ck < NCHUNK; ++ck) {
            const size_t r0 = (size_t)ck * MC;
            { pg8::Gemm g{HB + r0 * DM, Wb + W_IN, MC, INP, DM, DM}; pg8::StaticOrder S; S.init(MC, INP, G, bx);
              pg8::EpiGen E{ACT, INP, ssq1 + r0 * 16, 1.f / 1024.f, 1, PQ, PKV, rope, 16, 4}; pg8::gemm_phase(lds, wave_s, g, S, E); }
            XSYNC();
            { pg8::Gemm g{ACT + C_CQ, Wb + W_UQ, MC, QAW, 384, INP}; pg8::StaticOrder S; S.init(MC, QAW, G, bx);
              pg8::EpiGen E{QA, QAW, PQ, 1.f / 384.f, 2, nullptr, nullptr, rope, 16, 3}; pg8::gemm_phase(lds, wave_s, g, S, E); }
            { pg8::Gemm g{ACT + C_CKV, Wb + W_UKV, MC, KVAW, 256, INP}; pg8::StaticOrder S; S.init(MC, KVAW, G, bx);
              pg8::EpiGen E{KVA, KVAW, PKV, 1.f / 256.f, 0, nullptr, nullptr, rope, 8, 2}; pg8::gemm_phase(lds, wave_s, g, S, E); }
            XSYNC();
            {
            FRESH_IDS
            for (int u = vcu; u < NB_CHUNK * 16 * 8; u += G) {
                const int qb = u & 7, hh = (u >> 3) & 15, b = u >> 7; const size_t tok0 = (size_t)b * SEQ;
                f32x16 o[2];
                flash_core<96, 64, 0>(lds, wave_s, QA + (tok0 + 256 * qb) * QAW + 96 * hh, QAW, KVA + tok0 * KVAW + 128 * hh, KVAW, ACT + tok0 * INP + C_KR, INP,
                                      KVA + tok0 * KVAW + 128 * hh + 64, KVAW, 256 * qb, 0, SEQ / 64, (const LAS float*)(lds + ATT_LUT_OFF), 0.f, o);
                const int l2 = fresh_tid(wave_s) & 63;
                bf16_t* row = ACT + (tok0 + 256 * qb + 32 * wave + (l2 & 31)) * INP + C_GA + 64 * hh;
                attn_store<64, false>(o, row, row, l2 >> 5);
            }
            }
            {
            FRESH_IDS
            constexpr int SW_KBUF = 64 * 144, SW_VBUF = 8192, SW_LUT = 8 * SW_KBUF + 8 * SW_VBUF;
            for (int u = vcu; u < NB_CHUNK * 4 * 8; u += G) {
                const int qb = u & 7, kvh = (u >> 3) & 3, b = u >> 5; const size_t tok0 = (size_t)b * SEQ;
                const int q0 = 256 * qb; const int klo = max(0, (q0 - 128) >> 6), khi = min(SEQ / 64, (q0 + 384) >> 6);
                __syncthreads();
                { const int t2 = fresh_tid(wave_s); const int key = t2 >> 3, c = t2 & 7;
                  const bf16_t* kp = ACT + (tok0 + 64 * klo + key) * INP + C_KB + 64 * kvh + 8 * c; const bf16_t* vp = ACT + (tok0 + 64 * klo + key) * INP + C_VB + 64 * kvh + 8 * c;
                  LAS unsigned char* kd = lds + key * 144 + 16 * c; LAS unsigned char* vd = lds + 8 * SW_KBUF + (c >> 2) * 4096 + (key >> 3) * 512 + (key & 7) * 64 + (c & 3) * 16;
                  for (int i = 0; i < khi - klo; i += 2) {
                      const u32x4 k0 = *(const u32x4*)(kp + (size_t)(64 * i) * INP), v0 = *(const u32x4*)(vp + (size_t)(64 * i) * INP);
                      const u32x4 k1 = *(const u32x4*)(kp + (size_t)(64 * (i + 1)) * INP), v1 = *(const u32x4*)(vp + (size_t)(64 * (i + 1)) * INP);
                      *(LAS u32x4*)(kd + i * SW_KBUF) = k0; *(LAS u32x4*)(vd + i * SW_VBUF) = v0; *(LAS u32x4*)(kd + (i + 1) * SW_KBUF) = k1; *(LAS u32x4*)(vd + (i + 1) * SW_VBUF) = v1; } }
                const int qw0 = q0 + 32 * wave; int wlo = max(klo, (qw0 - 128) >> 6), whi = min(khi, ((qw0 + 159) >> 6) + 1);
                if ((whi - wlo) & 1) { if (whi < khi) ++whi; else --wlo; }
#pragma nounroll
                for (int g = 0; g < 4; ++g) {
                    const int hh = 4 * kvh + g;
                    __syncthreads();
                    build_lut_pad((LAS float*)(lds + SW_LUT), rel_table, hh, wave_s);
                    __syncthreads();
                    const float sink2 = a.in[12][L * 16 + hh] * LOG2E;
                    f32x16 o[2];
                    flash_core<64, 64, 1, true>(lds, wave_s, ACT + (tok0 + q0) * INP + C_QB + 64 * hh, INP, nullptr, 0, nullptr, 0, nullptr, 0, q0, wlo, whi,
                                                (const LAS float*)(lds + SW_LUT), sink2, o, klo);
                    const int l2 = fresh_tid(wave_s) & 63;
                    bf16_t* row = ACT + (tok0 + q0 + 32 * wave + (l2 & 31)) * INP;
                    attn_store<64, false>(o, row + C_GB + 64 * hh, row + C_GB + 64 * hh, l2 >> 5);
                }
            }
            }
            XSYNC();
            {
                FRESH_IDS
                int Lv = L; asm volatile("" : "+s"(Lv));
                const unsigned lib = (Lv == 0) ? __float_as_uint(0.2f) : (Lv == 1) ? __float_as_uint(0.35550906759096926f) : (Lv == 2) ? __float_as_uint(0.47071301834358416f) : __float_as_uint(0.5560582041556405f);
                const unsigned omb = (Lv == 0) ? __float_as_uint(0.8f) : (Lv == 1) ? __float_as_uint(0.64449093240903074f) : (Lv == 2) ? __float_as_uint(0.52928698165641584f) : __float_as_uint(0.4439417958443595f);
                const float lambda_init = __uint_as_float(lib);
                float s1 = 0.f, s2 = 0.f;
                for (int k_ = 0; k_ < 64; ++k_) { s1 += a.in[13][Lv * 64 + k_] * a.in[14][Lv * 64 + k_]; s2 += a.in[15][Lv * 64 + k_] * a.in[16][Lv * 64 + k_]; }
                const float lam = uniformf(expf(s1) - expf(s2) + lambda_init);
                const float* subln = a.in[17] + Lv * 128;
                float* scr_blk = (float*)(ws + WS_SCR) + (size_t)bx * (64 * 512);
                for (int u = vcu; u < NB_CHUNK * 8 * 8; u += G) {
                    const int qb = u & 7, hh = (u >> 3) & 7, b = u >> 6; const size_t tok0 = (size_t)b * SEQ; const int q0 = 256 * qb;
                    LAS float* lut = (LAS float*)(lds + ATT_LUT_OFF);
                    build_lut_dense(lut, rel_table, 16 + hh, wave_s);
                    { int Lw = Lv; asm volatile("" : "+s"(Lw));
                      const unsigned ob_ = (Lw == 0) ? __float_as_uint(0.8f) : (Lw == 1) ? __float_as_uint(0.64449093240903074f) : (Lw == 2) ? __float_as_uint(0.52928698165641584f) : __float_as_uint(0.4439417958443595f);
                      if (lane_id() == 0) ((LAS unsigned*)lut)[520] = ob_; }
                    f32x16 o[4];
                    flash_core<64, 128, 2>(lds, wave_s, ACT + (tok0 + q0) * INP + C_QC + 128 * hh, INP, ACT + tok0 * INP + C_KC + 128 * hh, INP, nullptr, 0,
                                           ACT + tok0 * INP + C_VC + 128 * hh, INP, q0, 0, SEQ / 64, lut, 0.f, o);
                    { f32x4* scr = (f32x4*)(scr_blk + (size_t)fresh_tid(wave_s) * 64);
#pragma unroll
                    for (int db = 0; db < 4; ++db)
#pragma unroll
                        for (int j = 0; j < 4; ++j) scr[db * 4 + j] = (f32x4){o[db][4 * j], o[db][4 * j + 1], o[db][4 * j + 2], o[db][4 * j + 3]}; }
                    flash_core<64, 128, 2>(lds, wave_s, ACT + (tok0 + q0) * INP + C_QC + 128 * hh + 64, INP, ACT + tok0 * INP + C_KC + 128 * hh + 64, INP, nullptr, 0,
                                           ACT + tok0 * INP + C_VC + 128 * hh, INP, q0, 0, SEQ / 64, lut, 0.f, o);
                    float ss = 0.f;
                    const int t3 = fresh_tid(wave_s), l3 = t3 & 63;
                    const f32x4* scr = (const f32x4*)(scr_blk + (size_t)t3 * 64);
#pragma unroll
                    for (int db = 0; db < 4; ++db)
                    {
#pragma unroll
                      for (int j = 0; j < 4; ++j) { const f32x4 t4 = scr[db * 4 + j];
#pragma unroll
                            for (int e = 0; e < 4; ++e) { const float v = t4[e] - lam * o[db][4 * j + e]; o[db][4 * j + e] = v; ss += v * v; } }
                      __builtin_amdgcn_sched_barrier(0); }
                    ss += __shfl_xor(ss, 32);
                    const float rs = rsqrtf(ss * (1.f / 128.f) + EPS) * lut[520];
                    const int hl = l3 >> 5;
#pragma unroll
                    for (int db = 0; db < 4; ++db)
                    {
                      int so_ = 32 * db + 4 * hl; asm volatile("" : "+v"(so_));
#pragma unroll
                      for (int rg = 0; rg < 4; ++rg) { const f32x4 gn = *(const f32x4*)(subln + so_ + 8 * rg);
#pragma unroll
                            for (int e = 0; e < 4; ++e) o[db][4 * rg + e] *= rs * gn[e]; }
                      asm volatile("" : "+v"(o[db])); __builtin_amdgcn_sched_barrier(0); }
                    bf16_t* row = ACT + (tok0 + q0 + 32 * wave + (l3 & 31)) * INP;
                    attn_store<128, true, true>(o, row + C_GC + 128 * hh, row + C_GA + 128 * hh, hl, row + C_GB + 128 * hh);
                }
            }
            XSYNC();
            { pg8::Gemm g{ACT + C_GA, Wb + W_OUT, MC, DM, DM, INP}; pg8::StaticOrder S; S.init(MC, DM, G, bx);
              pg8::EpiResid<false> E{HB + r0 * DM, HB + r0 * DM, LOP + r0 * DM, ssq2 + r0 * 16, nullptr, nullptr, 1.0f, 0.f}; pg8::gemm_phase(lds, wave_s, g, S, E); }
            XSYNC();
        }
        { pg8::Gemm g{HB, Wb + W_GU2, MTOK, 2 * DFF, DM, DM}; pg8::StaticOrder S; S.init(MTOK, 2 * DFF, G, bx);
          pg8::EpiSwiglu E{HID, ssq2}; pg8::gemm_phase(lds, wave_s, g, S, E); }
        { pg8::Gemm g{PB, Wb + W_PP, MTOK, DM, PLE, PLE}; pg8::StaticOrder S; S.init(MTOK, DM, G, bx);
          pg8::EpiGen E{PPJ, DM, nullptr, 0.f, 0, nullptr, nullptr, rope, 16, 0}; pg8::gemm_phase(lds, wave_s, g, S, E); }
        XSYNC();
        { pg8::Gemm g{HID, Wb + W_D2, MTOK, DM, DFF, DFF}; pg8::StaticOrder S; S.init(MTOK, DM, G, bx);
          pg8::EpiResid<false> E{HB, HB, LOP, ssq3, nullptr, nullptr, 0.5f, 0.f}; pg8::gemm_phase(lds, wave_s, g, S, E); }
        XSYNC();
        { pg8::Gemm g{HB, Wb + W_PG, MTOK, DM, DM, DM}; pg8::StaticOrder S; S.init(MTOK, DM, G, bx);
          pg8::EpiResid<true> E{HB, QA, LOP, ssq4, ssq3, PPJ, 1.0f, 0.f}; pg8::gemm_phase(lds, wave_s, g, S, E); }
        XSYNC();
    }
    {
        FRESH_IDS
        const float* fg = a.in[27]; const float* ssqf = PH0;
        bf16_t* LOC = ACT;
#pragma nounroll
        for (int stage = 0; stage < 2; ++stage) {
            const int mbeg = stage * (MTOK / 2);
            const bf16_t* lsrc = stage ? (LOC - (size_t)(MTOK / 2) * DM) : LOP;
            for (int m = mbeg + gw; m < mbeg + MTOK / 2; m += NGW) {
                f32x4* hr = (f32x4*)(Hf + (size_t)m * DM) + lane; const u32x2* hb = (const u32x2*)(QA + (size_t)m * DM) + lane; const u32x2* lb = (const u32x2*)(lsrc + (size_t)m * DM) + lane;
                const f32x4* pp_ = (const f32x4*)(ssqf + (size_t)m * 16); const f32x4 q0_ = pp_[0], q1_ = pp_[1], q2_ = pp_[2], q3_ = pp_[3];
                const float tot_ = (((q0_[0] + q0_[1]) + (q0_[2] + q0_[3])) + ((q1_[0] + q1_[1]) + (q1_[2] + q1_[3]))) + (((q2_[0] + q2_[1]) + (q2_[2] + q2_[3])) + ((q3_[0] + q3_[1]) + (q3_[2] + q3_[3])));
                const float rs = rsqrtf(tot_ * (1.f / 1024.f) + EPS);
#pragma unroll
                for (int j = 0; j < 4; ++j) { const f32x4 gn = *((const f32x4*)fg + lane + 64 * j); const u32x2 wh = hb[64 * j], wl = lb[64 * j];
                    f32x4 v = (f32x4){bflo(wh.x) + bflo(wl.x), bfhi(wh.x) + bfhi(wl.x), bflo(wh.y) + bflo(wl.y), bfhi(wh.y) + bfhi(wl.y)}; v = v * rs * gn; hr[64 * j] = v; }
            }
            if (stage == 0) {
                const u32x4* src = (const u32x4*)(LOP + (size_t)(MTOK / 2) * DM); u32x4* dst = (u32x4*)LOC;
                const int gt = gw * 64 + lane, NGT = NGW * 64;
                for (int i = gt; i < (MTOK / 2) * DM / 8; i += NGT) dst[i] = src[i];
                XSYNC();
            }
        }
    }
}

constexpr int LDS_BYTES = 147456;

extern "C" void kernel_launch(void* const* d_in, const int* in_sizes, int n_in, void* d_out, int out_size, void* d_ws, size_t ws_size, hipStream_t stream) {
    static int grid = 0;
    if (grid == 0) {
        if (n_in != 28 || out_size != MTOK * DM || ws_size < WS_END) { fprintf(stderr, "kernel_launch: unexpected shapes (n_in %d out %d ws %zu)\n", n_in, out_size, ws_size); grid = -1; return; }
        int dev = 0, cus = 0, per_cu = 0;
        hipGetDevice(&dev);
        hipDeviceGetAttribute(&cus, hipDeviceAttributeMultiprocessorCount, dev);
        hipFuncSetAttribute((const void*)fwd_megakernel, hipFuncAttributeMaxDynamicSharedMemorySize, LDS_BYTES);
        hipOccupancyMaxActiveBlocksPerMultiprocessor(&per_cu, (const void*)fwd_megakernel, 512, LDS_BYTES);
        if (per_cu < 1) per_cu = 1;
        if (per_cu > 1) per_cu = 1;
        grid = cus * per_cu;
        if (grid > 256) grid = 256;
        (void)hipGetLastError();
    }
    if (grid < 0) return;
    Args a{};
    for (int i = 0; i < 28; ++i) a.in[i] = (const float*)d_in[i];
    a.out = (float*)d_out; a.ws = (unsigned char*)d_ws;
    (void)hipMemsetAsync((char*)d_ws + WS_BAR, 0, 16384, stream);
    void* kargs[] = {&a};
    hipError_t e = hipLaunchCooperativeKernel((const void*)fwd_megakernel, dim3(grid), dim3(512), kargs, LDS_BYTES, stream);
    if (e != hipSuccess) fprintf(stderr, "cooperative launch failed: %s (grid %d)\n", hipGetErrorString(e), grid);
}
```

```cpp
#include <hip/hip_runtime.h>
#include <hip/hip_cooperative_groups.h>
#include <cstdio>
#include <cstdint>
#include <cmath>
namespace cg = cooperative_groups;

#define LAS __attribute__((address_space(3)))
typedef unsigned short bf16_t;
typedef short bf16x8 __attribute__((ext_vector_type(8)));
typedef float f32x4 __attribute__((ext_vector_type(4)));
typedef float f32x16 __attribute__((ext_vector_type(16)));
typedef unsigned u32x4 __attribute__((ext_vector_type(4)));
typedef unsigned u32x2 __attribute__((ext_vector_type(2)));
typedef short v4i16_t __attribute__((ext_vector_type(4)));
typedef float f32x2_t __attribute__((ext_vector_type(2)));
typedef __bf16 bf16x2_t __attribute__((ext_vector_type(2)));

constexpr int DM = 1024, SEQ = 2048, DEPTH = 4, MTOK = 65536, DFF = 2816, PLE = 256;
constexpr int NB_CHUNK = 16, MC = NB_CHUNK * SEQ, NCHUNK = 2;
constexpr int INW = 8352, INP = 8448;
constexpr int C_CQ = 0, C_CKV = 384, C_KR = 640, C_QB = 768, C_KB = 1792, C_VB = 2048, C_QC = 2304, C_KC = 3328, C_VC = 4352, C_GA = 5376, C_GB = 6400, C_GC = 7424;
constexpr int QAW = 1536, KVAW = 2048;
constexpr float EPS = 1e-6f;
constexpr float LOG2E = 1.4426950408889634f;
constexpr float C2_64 = 0.125f * 1.4426950408889634f;
constexpr float C2_96 = 0.10206207261596577f * 1.4426950408889634f;

constexpr size_t MiB = 1u << 20;
constexpr size_t WS_PH0 = 0, WS_PQ = 4 * MiB, WS_PKV = 6 * MiB;
constexpr size_t WS_PH1 = 1012 * MiB, WS_PH2 = 1016 * MiB, WS_PH3 = 1020 * MiB;
constexpr size_t WS_ROPE = 7 * MiB;
constexpr size_t WS_BAR = 7 * MiB + 512 * 1024;
constexpr size_t WS_W = 8 * MiB;
constexpr size_t WS_PB = 66 * MiB;
constexpr size_t WS_HB = 98 * MiB;
constexpr size_t WS_ACT = 226 * MiB;
constexpr size_t WS_QA = 754 * MiB;
constexpr size_t WS_KVA = 850 * MiB;
constexpr size_t WS_HID = 226 * MiB;
constexpr size_t WS_PPJ = 578 * MiB;
constexpr size_t WS_SCR = 980 * MiB;
constexpr size_t WS_END = 1024 * MiB;
constexpr size_t W_GU1 = 0, W_D1 = W_GU1 + (size_t)2 * DFF * DM, W_IN = W_D1 + (size_t)DM * DFF, W_UQ = W_IN + (size_t)INP * DM,
                 W_UKV = W_UQ + (size_t)QAW * 384, W_OUT = W_UKV + (size_t)KVAW * 256, W_GU2 = W_OUT + (size_t)DM * DM,
                 W_D2 = W_GU2 + (size_t)2 * DFF * DM, W_PG = W_D2 + (size_t)DM * DFF, W_PP = W_PG + (size_t)DM * DM, W_ENDE = W_PP + (size_t)DM * PLE;
static_assert(W_ENDE * 2 <= 58 * MiB, "weights fit");

__device__ __forceinline__ unsigned pk2(float lo, float hi) { f32x2_t v = {lo, hi}; bf16x2_t b = __builtin_convertvector(v, bf16x2_t); return __builtin_bit_cast(unsigned, b); }
__device__ __forceinline__ float bflo(unsigned u) { return __uint_as_float(u << 16); }
__device__ __forceinline__ float bfhi(unsigned u) { return __uint_as_float(u & 0xffff0000u); }
__device__ __forceinline__ float wave_sum(float v) {
#pragma unroll
    for (int o = 1; o < 64; o <<= 1) v += __shfl_xor(v, o);
    return v;
}
__device__ __forceinline__ float max3f(float a, float b, float c) { float r; asm("v_max3_f32 %0, %1, %2, %3" : "=v"(r) : "v"(a), "v"(b), "v"(c)); return r; }
__device__ __forceinline__ float max2f(float a, float b) { float r; asm("v_max_f32_e32 %0, %1, %2" : "=v"(r) : "v"(a), "v"(b)); return r; }
__device__ __forceinline__ float fast_sigmoid(float x) { return __builtin_amdgcn_rcpf(1.f + __expf(-x)); }
__device__ __forceinline__ int lane_id() { int r; asm volatile("v_mbcnt_lo_u32_b32 %0, -1, 0\n\tv_mbcnt_hi_u32_b32 %0, -1, %0" : "=&v"(r)); return r; }
__device__ __forceinline__ int fresh_tid(int wave_s) { return wave_s * 64 + lane_id(); }
__device__ __forceinline__ float uniformf(float v) { return __uint_as_float(__builtin_amdgcn_readfirstlane(__float_as_uint(v))); }
__device__ __forceinline__ void atomic_addf(float* p, float v) { __hip_atomic_fetch_add(p, v, __ATOMIC_RELAXED, __HIP_MEMORY_SCOPE_AGENT); }

__device__ __forceinline__ float row_ssq(const float* part, int pitch, int n4, int row, int fq) {
    f32x4 v = (f32x4){0.f, 0.f, 0.f, 0.f};
    if (fq < n4) v = *(const f32x4*)(part + (size_t)row * pitch + 4 * fq);
    float s = (v[0] + v[1]) + (v[2] + v[3]);
    s += __shfl_xor(s, 16); s += __shfl_xor(s, 32);
    return s;
}
namespace pg8 {
constexpr int BM = 256, BK = 64, HALF = 128, HTB = HALF * BK * 2, STAGE_BYTES = 8 * HTB, NXCD = 8, WGM = 8;
__device__ __forceinline__ int lds_byte(int r, int c) { const int st = (r >> 4) * 2 + (c >> 5), rr = r & 15, cc = c & 31, ob = rr * 64 + cc * 2; return st * 1024 + (ob ^ (((ob >> 9) & 1) << 5)); }
__device__ __forceinline__ void stage_rc(int b, int& R, int& C) { const int st = b / 1024, sb = b % 1024, swz = sb ^ (((sb >> 9) & 1) << 5); R = (st >> 1) * 16 + swz / 64; C = (st & 1) * 32 + (swz % 64) / 2; }
__device__ __forceinline__ int perm32(int rho) { const int n = rho >> 4, i = rho & 15; return 8 * (i >> 2) + 4 * n + (i & 3); }

struct Unit { int pm, pn; };
struct Gemm { const bf16_t* A; const bf16_t* Bt; int M, N, K, lda; };

struct StaticOrder {
    int nM, nN, nwg, G, c;
    __device__ __forceinline__ void init(int M, int N, int G_, int c_) { nM = M / BM; nN = N / BM; nwg = nM * nN; G = G_; c = c_; }
    __device__ __forceinline__ bool next(int i, Unit& u) const {
        const long L = (long)i * G + c; if (L >= nwg) return false;
        int wgid = (int)L; { const int q = nwg / NXCD, r = nwg % NXCD, xcd = wgid % NXCD, off = wgid / NXCD; wgid = (xcd < r ? xcd * (q + 1) : r * (q + 1) + (xcd - r) * q) + off; }
        const int nig = WGM * nN, gid = wgid / nig, fm = gid * WGM, gsz = (nM - fm) < WGM ? (nM - fm) : WGM;
        u.pm = fm + ((wgid % nig) % gsz); u.pn = (wgid % nig) / gsz; return true;
    }
};

template <class Epi>
__device__ __forceinline__ void gemm_phase(LAS unsigned char* lds, int wave_s, const Gemm g, const StaticOrder S, const Epi E) {
    const int tid = fresh_tid(wave_s);
    const int wid = __builtin_amdgcn_readfirstlane(tid >> 6), lane = tid & 63, wr = wid >> 2, wc = wid & 3, fr = lane & 15, fq = lane >> 4;
    const int K = g.K, nt = K / BK, lda = g.lda;
    unsigned voffA[2], voffB[2];
#pragma unroll
    for (int i = 0; i < 2; ++i) { int R, C; stage_rc(tid * 16 + i * 8192, R, C); const int Rb = Epi::PERM ? ((R & ~31) + perm32(R & 31)) : R;
        voffA[i] = (unsigned)(R * lda + C) * 2u; voffB[i] = (unsigned)(Rb * K + C) * 2u; }
    const size_t kstep = (size_t)(BK * 2);
    const size_t hstepA = (size_t)HALF * lda * 2, hstepB = (size_t)HALF * K * 2;
    const size_t tstepA = 2 * hstepA, tstepB = 2 * hstepB;
    const unsigned ldsw = (unsigned)wid * 1024u;
    const int aoff = lds_byte(wr * 64 + fr, fq * 8), boff = lds_byte(wc * 32 + fr, fq * 8);
#define PG8_SA(b, h) (((b) * 2 + (h)) * HTB)
#define PG8_SB(b, h) ((4 + (b) * 2 + (h)) * HTB)
#define PG8_STAGE(bufoff, gbase, voff) do { _Pragma("unroll") for (int _i = 0; _i < 2; ++_i) \
        __builtin_amdgcn_global_load_lds((const unsigned*)((const char*)(gbase) + (voff)[_i]), (LAS unsigned*)(lds + (bufoff) + ldsw + _i * 8192), 16, 0, 0); } while (0)
#define PG8_LDA(dst, b, h) do { _Pragma("unroll") for (int m = 0; m < 4; ++m) _Pragma("unroll") for (int k = 0; k < 2; ++k) dst[m][k] = *(const LAS bf16x8*)(lds + PG8_SA(b, h) + aoff + m * 2048 + k * 1024); } while (0)
#define PG8_LDB(dst, b, h) do { _Pragma("unroll") for (int n = 0; n < 2; ++n) _Pragma("unroll") for (int k = 0; k < 2; ++k) dst[n][k] = *(const LAS bf16x8*)(lds + PG8_SB(b, h) + boff + n * 2048 + k * 1024); } while (0)
#define PG8_MMA(ai, bj, At, Bt) do { __builtin_amdgcn_s_setprio(1); _Pragma("unroll") for (int m = 0; m < 4; ++m) _Pragma("unroll") for (int n = 0; n < 2; ++n) _Pragma("unroll") for (int k = 0; k < 2; ++k) \
        acc[ai][bj][m][n] = __builtin_amdgcn_mfma_f32_16x16x32_bf16(Bt[n][k], At[m][k], acc[ai][bj][m][n], 0, 0, 0); __builtin_amdgcn_s_setprio(0); } while (0)
#define PG8_WAIT_V(n) asm volatile("s_waitcnt vmcnt(" #n ")" ::: "memory")
#define PG8_WAIT_L(n) asm volatile("s_waitcnt lgkmcnt(" #n ")" ::: "memory")
#define PG8_BAR __builtin_amdgcn_s_barrier()
#define PG8_SCHED __builtin_amdgcn_sched_barrier(0)
    Unit cur, nxt; int ui = 0;
    if (!S.next(0, cur)) return;
    f32x4 acc[2][2][4][2];
#pragma unroll
    for (int a = 0; a < 2; ++a)
#pragma unroll
        for (int b = 0; b < 2; ++b)
#pragma unroll
            for (int m = 0; m < 4; ++m)
#pragma unroll
                for (int n = 0; n < 2; ++n) acc[a][b][m][n] = (f32x4){0.f, 0.f, 0.f, 0.f};
    bf16x8 At[4][2], B0[2][2], B1[2][2];
    const char* cA = (const char*)g.A + (size_t)cur.pm * tstepA; const char* cB = (const char*)g.Bt + (size_t)cur.pn * tstepB;
    PG8_STAGE(PG8_SB(0, 0), cB, voffB); PG8_STAGE(PG8_SB(0, 1), cB + hstepB, voffB); PG8_STAGE(PG8_SA(0, 0), cA, voffA); PG8_STAGE(PG8_SA(0, 1), cA + hstepA, voffA);
    if (wr == 1) PG8_BAR;
    PG8_WAIT_V(2); PG8_BAR;
    PG8_STAGE(PG8_SB(1, 0), cB + kstep, voffB); PG8_STAGE(PG8_SA(1, 0), cA + kstep, voffA); PG8_STAGE(PG8_SB(1, 1), cB + hstepB + kstep, voffB);
    PG8_WAIT_V(6); PG8_BAR;
    for (;;) {
        const bool has_next = S.next(ui + 1, nxt);
        const char* nA = has_next ? (const char*)g.A + (size_t)nxt.pm * tstepA : cA; const char* nB = has_next ? (const char*)g.Bt + (size_t)nxt.pn * tstepB : cB;
        for (int t = 0; t < nt; t += 2) {
            const bool last = (t == nt - 2);
            const char* a1 = cA + (size_t)(t + 1) * kstep;
            const char* a2 = last ? nA : cA + (size_t)(t + 2) * kstep; const char* b2 = last ? nB : cB + (size_t)(t + 2) * kstep;
            const char* a3 = a2 + kstep; const char* b3 = b2 + kstep;
            PG8_LDB(B0, 0, 0); PG8_LDB(B1, 0, 1); PG8_SCHED; PG8_LDA(At, 0, 0); PG8_STAGE(PG8_SA(1, 1), a1 + hstepA, voffA);
            PG8_WAIT_V(8); PG8_WAIT_L(0); PG8_BAR; PG8_MMA(0, 0, At, B0); PG8_MMA(0, 1, At, B1); PG8_BAR; PG8_SCHED;
            PG8_LDA(At, 0, 1); PG8_STAGE(PG8_SB(0, 0), b2, voffB); PG8_STAGE(PG8_SB(0, 1), b2 + hstepB, voffB); PG8_STAGE(PG8_SA(0, 0), a2, voffA);
            PG8_WAIT_V(8); PG8_WAIT_L(0); PG8_BAR; PG8_MMA(1, 0, At, B0); PG8_MMA(1, 1, At, B1); PG8_BAR; PG8_SCHED;
            PG8_LDB(B0, 1, 0); PG8_LDB(B1, 1, 1); PG8_SCHED; PG8_LDA(At, 1, 0); PG8_STAGE(PG8_SA(0, 1), a2 + hstepA, voffA);
            PG8_WAIT_V(8); PG8_WAIT_L(0); PG8_BAR; PG8_MMA(0, 0, At, B0); PG8_MMA(0, 1, At, B1); PG8_BAR; PG8_SCHED;
            PG8_LDA(At, 1, 1); PG8_STAGE(PG8_SB(1, 0), b3, voffB); PG8_STAGE(PG8_SB(1, 1), b3 + hstepB, voffB); PG8_STAGE(PG8_SA(1, 0), a3, voffA);
            PG8_WAIT_V(8); PG8_WAIT_L(0); PG8_BAR; PG8_MMA(1, 0, At, B0); PG8_MMA(1, 1, At, B1); PG8_BAR; PG8_SCHED;
        }
        if (wr == 0) PG8_BAR;
        E(acc, cur, wr, wc, fr, fq);
        if (!has_next) break;
#pragma unroll
        for (int a = 0; a < 2; ++a)
#pragma unroll
            for (int b = 0; b < 2; ++b)
#pragma unroll
                for (int m = 0; m < 4; ++m)
#pragma unroll
                    for (int n = 0; n < 2; ++n) acc[a][b][m][n] = (f32x4){0.f, 0.f, 0.f, 0.f};
        cur = nxt; cA = nA; cB = nB; ++ui;
        if (wr == 1) PG8_BAR;
    }
    PG8_WAIT_V(0);
    PG8_BAR;
#undef PG8_SA
#undef PG8_SB
#undef PG8_STAGE
#undef PG8_LDA
#undef PG8_LDB
#undef PG8_MMA
#undef PG8_WAIT_V
#undef PG8_WAIT_L
#undef PG8_BAR
#undef PG8_SCHED
}

struct EpiSwiglu {
    static constexpr bool PERM = true;
    bf16_t* O; const float* ssq;
    __device__ __forceinline__ void operator()(const f32x4 (&acc)[2][2][4][2], const Unit& u, int wr, int wc, int fr, int fq) const {
        const int row0 = u.pm * BM + wr * 64 + fr, col0 = u.pn * 128 + wc * 32 + 8 * fq;
#pragma unroll
        for (int ai = 0; ai < 2; ++ai)
#pragma unroll
            for (int m = 0; m < 4; ++m) {
                const int row = row0 + ai * HALF + m * 16;
                const float rs = rsqrtf(row_ssq(ssq, 16, 4, row, fq) * (1.f / 1024.f) + EPS);
                float r[8];
#pragma unroll
                for (int n = 0; n < 2; ++n)
#pragma unroll
                    for (int e = 0; e < 4; ++e) { const float gv = acc[ai][0][m][n][e] * rs, uv = acc[ai][1][m][n][e] * rs; r[n * 4 + e] = gv * fast_sigmoid(gv) * uv; }
                u32x4 w; w.x = pk2(r[0], r[1]); w.y = pk2(r[2], r[3]); w.z = pk2(r[4], r[5]); w.w = pk2(r[6], r[7]);
                *(u32x4*)(O + (size_t)row * DFF + col0) = w;
            }
    }
};
template <bool GATED>
struct EpiResid {
    static constexpr bool PERM = true;
    const bf16_t* HI; bf16_t* HO; bf16_t* LO; float* ssq_out; const float* ssq_in; const bf16_t* PP; float alpha; float pad_;
    __device__ __forceinline__ void operator()(const f32x4 (&acc)[2][2][4][2], const Unit& u, int wr, int wc, int fr, int fq) const {
        const int row0 = u.pm * BM + wr * 64 + fr, col0 = u.pn * BM + wc * 32 + 8 * fq;
#pragma unroll
        for (int ai = 0; ai < 2; ++ai)
#pragma unroll
            for (int m = 0; m < 4; ++m) {
                const int row = row0 + ai * HALF + m * 16;
                float rs = 0.f; if (GATED) rs = rsqrtf(row_ssq(ssq_in, 16, 4, row, fq) * (1.f / 1024.f) + EPS);
                float sq = 0.f;
#pragma unroll
                for (int bj = 0; bj < 2; ++bj) {
                    const size_t off = (size_t)row * DM + col0 + bj * HALF;
                    const u32x4 hh = *(const u32x4*)(HI + off), ll = *(const u32x4*)(LO + off);
                    float hv[8] = {bflo(hh.x) + bflo(ll.x), bfhi(hh.x) + bfhi(ll.x), bflo(hh.y) + bflo(ll.y), bfhi(hh.y) + bfhi(ll.y),
                                   bflo(hh.z) + bflo(ll.z), bfhi(hh.z) + bfhi(ll.z), bflo(hh.w) + bflo(ll.w), bfhi(hh.w) + bfhi(ll.w)};
                    float av[8] = {acc[ai][bj][m][0][0], acc[ai][bj][m][0][1], acc[ai][bj][m][0][2], acc[ai][bj][m][0][3], acc[ai][bj][m][1][0], acc[ai][bj][m][1][1], acc[ai][bj][m][1][2], acc[ai][bj][m][1][3]};
                    if (GATED) { const u32x4 pp = *(const u32x4*)(PP + off);
                        const float pv[8] = {bflo(pp.x), bfhi(pp.x), bflo(pp.y), bfhi(pp.y), bflo(pp.z), bfhi(pp.z), bflo(pp.w), bfhi(pp.w)};
#pragma unroll
                        for (int e = 0; e < 8; ++e) av[e] = fast_sigmoid(av[e] * rs) * pv[e]; }
                    else {
#pragma unroll
                        for (int e = 0; e < 8; ++e) av[e] *= alpha; }
                    float lo[8];
#pragma unroll
                    for (int e = 0; e < 8; ++e) { hv[e] += av[e]; sq += hv[e] * hv[e]; }
                    u32x4 wh; wh.x = pk2(hv[0], hv[1]); wh.y = pk2(hv[2], hv[3]); wh.z = pk2(hv[4], hv[5]); wh.w = pk2(hv[6], hv[7]);
                    lo[0] = hv[0] - bflo(wh.x); lo[1] = hv[1] - bfhi(wh.x); lo[2] = hv[2] - bflo(wh.y); lo[3] = hv[3] - bfhi(wh.y);
                    lo[4] = hv[4] - bflo(wh.z); lo[5] = hv[5] - bfhi(wh.z); lo[6] = hv[6] - bflo(wh.w); lo[7] = hv[7] - bfhi(wh.w);
                    u32x4 wl; wl.x = pk2(lo[0], lo[1]); wl.y = pk2(lo[2], lo[3]); wl.z = pk2(lo[4], lo[5]); wl.w = pk2(lo[6], lo[7]);
                    *(u32x4*)(HO + off) = wh; *(u32x4*)(LO + off) = wl;
                }
                sq += __shfl_xor(sq, 16); sq += __shfl_xor(sq, 32);
                if (fq == 0) ssq_out[(size_t)row * 16 + 4 * u.pn + wc] = sq;
            }
    }
};
struct EpiGen {
    static constexpr bool PERM = true;
    bf16_t* O; int ldc; const float* ssq_in; float inv_k; int mode; float* ssq_q; float* ssq_kv; const float* rope; int in_pitch; int in_n4;
    __device__ __forceinline__ void operator()(const f32x4 (&acc)[2][2][4][2], const Unit& u, int wr, int wc, int fr, int fq) const {
        const int row0 = u.pm * BM + wr * 64 + fr;
        float rsv[2][4];
#pragma unroll
        for (int ai = 0; ai < 2; ++ai)
#pragma unroll
            for (int m = 0; m < 4; ++m) rsv[ai][m] = ssq_in ? rsqrtf(row_ssq(ssq_in, in_pitch, in_n4, row0 + ai * HALF + m * 16, fq) * inv_k + EPS) : 1.f;
#pragma unroll
        for (int bj = 0; bj < 2; ++bj) {
            const int c0 = u.pn * BM + bj * HALF + wc * 32;
            float scale = 1.f; bool sig = false, rp = false, st = true; float* sq = nullptr; int sqp = 0;
            if (mode == 1) { const int slab = c0 >> 7;
                if (slab < 3) { sq = ssq_q + 4 * slab + wc; sqp = 16; } else if (slab < 5) { sq = ssq_kv + 4 * (slab - 3) + wc; sqp = 8; } else if (slab == 5) { rp = (wc == 0); st = (wc == 0); }
                else if (slab < 14) scale = C2_64; else if (slab < 18) {} else if (slab < 26) scale = C2_64; else if (slab < 42) {} else sig = true;
            } else if (mode == 2) { rp = ((c0 % 96) == 64); scale = C2_96; }
            if (!st) continue;
#pragma unroll
            for (int ai = 0; ai < 2; ++ai)
#pragma unroll
                for (int m = 0; m < 4; ++m) {
                    const int row = row0 + ai * HALF + m * 16; const float rs = rsv[ai][m] * scale;
                    f32x4 v0 = acc[ai][bj][m][0] * rs, v1 = acc[ai][bj][m][1] * rs;
                    if (rp) {
                        const int pos = row & (SEQ - 1); const float* rb = rope + pos * 32 + 8 * (fq & 1); const bool hi2 = (fq >> 1) != 0;
                        const f32x4 cs0 = *(const f32x4*)(rb), cs1 = *(const f32x4*)(rb + 4), sn0 = *(const f32x4*)(rb + 16), sn1 = *(const f32x4*)(rb + 20);
#pragma unroll
                        for (int e = 0; e < 4; ++e) { const float q0 = __shfl_xor(v0[e], 32), q1 = __shfl_xor(v1[e], 32);
                            v0[e] = hi2 ? v0[e] * cs0[e] + q0 * sn0[e] : v0[e] * cs0[e] - q0 * sn0[e];
                            v1[e] = hi2 ? v1[e] * cs1[e] + q1 * sn1[e] : v1[e] * cs1[e] - q1 * sn1[e]; } }
                    if (sig) {
#pragma unroll
                        for (int e = 0; e < 4; ++e) { v0[e] = fast_sigmoid(v0[e]); v1[e] = fast_sigmoid(v1[e]); } }
                    if (sq) { float s = (v0[0] * v0[0] + v0[1] * v0[1]) + (v0[2] * v0[2] + v0[3] * v0[3]) + (v1[0] * v1[0] + v1[1] * v1[1]) + (v1[2] * v1[2] + v1[3] * v1[3]);
                        s += __shfl_xor(s, 16); s += __shfl_xor(s, 32); if (fq == 0) sq[(size_t)row * sqp] = s; }
                    u32x4 w; w.x = pk2(v0[0], v0[1]); w.y = pk2(v0[2], v0[3]); w.z = pk2(v1[0], v1[1]); w.w = pk2(v1[2], v1[3]);
                    *(u32x4*)(O + (size_t)row * ldc + c0 + 8 * fq) = w;
                }
        }
    }
};
}

constexpr int ATT_LUT_OFF = 61440;
template <int DQK, int DV, int MODE, bool RES = false>
__device__ __forceinline__ void flash_core(LAS unsigned char* lds, int wave_s, const bf16_t* Qp, int qpitch, const bf16_t* K1, int k1pitch, const bf16_t* K2, int k2pitch,
                                           const bf16_t* Vp, int vpitch, int q0, int kt_lo, int kt_hi, const LAS float* lut, float sink2, f32x16 (&o)[DV / 32], int win_lo = 0) {
    constexpr int CH = DQK / 8, KS = DQK * 2 + 16, KBUF = 64 * KS, VBUF = 64 * DV * 2, VCH = DV / 8;
    constexpr int NKI = (64 * CH + 511) / 512, NVI = (64 * VCH) / 512, NDB = DV / 32;
    static_assert(RES || 2 * KBUF + 2 * VBUF <= ATT_LUT_OFF, "attention LDS");
    LAS unsigned char* Kl = lds; LAS unsigned char* Vl = lds + (RES ? 8 : 2) * KBUF;
    const int tid = fresh_tid(wave_s);
    const int lane = tid & 63, wid = __builtin_amdgcn_readfirstlane(tid >> 6), r32 = lane & 31, h = lane >> 5;
    bf16x8 qf[DQK / 16];
    { const bf16_t* qrow = Qp + (size_t)(32 * wid + r32) * qpitch + 8 * h;
#pragma unroll
      for (int d0 = 0; d0 < DQK / 16; ++d0) qf[d0] = *(const bf16x8*)(qrow + 16 * d0); }
    float mrun = -INFINITY, lrun = 0.f;
#pragma unroll
    for (int db = 0; db < NDB; ++db)
#pragma unroll
        for (int r = 0; r < 16; ++r) o[db][r] = 0.f;
    const int qw0 = q0 + 32 * wid, qpos = qw0 + r32;
    const bf16x8 ones = (bf16x8){(short)0x3F80, (short)0x3F80, (short)0x3F80, (short)0x3F80, (short)0x3F80, (short)0x3F80, (short)0x3F80, (short)0x3F80};
    u32x4 kreg[NKI], vreg[NVI];
    const unsigned char* ksrc[NKI]; unsigned kstep[NKI]; int kdst[NKI]; bool kval[NKI];
#pragma unroll
    for (int i_ = 0; i_ < NKI; ++i_) { const int idx = tid + 512 * i_; const int key = idx / CH, c = idx % CH; kval[i_] = (idx < 64 * CH);
        if (c < 8) { ksrc[i_] = (const unsigned char*)(K1 + (size_t)key * k1pitch + 8 * c); kstep[i_] = (unsigned)(128 * k1pitch); }
        else       { ksrc[i_] = (const unsigned char*)(K2 + (size_t)key * k2pitch + 8 * (c - 8)); kstep[i_] = (unsigned)(128 * k2pitch); }
        if (!kval[i_]) { ksrc[i_] = (const unsigned char*)K1; kstep[i_] = 0u; }
        kdst[i_] = key * KS + 16 * c; }
    const unsigned char* vsrc0; int vdst0;
    { const int key = tid / VCH, c = tid % VCH; vsrc0 = (const unsigned char*)(Vp + (size_t)key * vpitch + 8 * c); vdst0 = (c >> 2) * 4096 + (key >> 3) * 512 + (key & 7) * 64 + (c & 3) * 16; }
    const unsigned vrowoff = (unsigned)((512 / VCH) * vpitch * 2);
    constexpr int VDSTOFF = ((512 / VCH) >> 3) * 512;
    const unsigned vstep = (unsigned)(128 * vpitch);
#define FA_LOADK(kt) do { _Pragma("unroll") for (int i_ = 0; i_ < NKI; ++i_) kreg[i_] = *(const u32x4*)(ksrc[i_] + (size_t)(unsigned)(kt) * kstep[i_]); } while (0)
#define FA_LOADV(kt) do { _Pragma("unroll") for (int i_ = 0; i_ < NVI; ++i_) vreg[i_] = *(const u32x4*)(vsrc0 + (size_t)(unsigned)(kt) * vstep + (size_t)i_ * vrowoff); } while (0)
#define FA_STOREK(buf) do { _Pragma("unroll") for (int i_ = 0; i_ < NKI; ++i_) { if (kval[i_]) *(LAS u32x4*)(Kl + (buf) * KBUF + kdst[i_]) = kreg[i_]; } } while (0)
#define FA_STOREV(buf) do { _Pragma("unroll") for (int i_ = 0; i_ < NVI; ++i_) *(LAS u32x4*)(Vl + (buf) * VBUF + vdst0 + i_ * VDSTOFF) = vreg[i_]; } while (0)
#define FA_QK(P0, P1, kbuf, CI) do { const LAS unsigned char* kb_ = Kl + (kbuf) * KBUF + r32 * KS + 16 * h; \
    _Pragma("unroll") for (int d0 = 0; d0 < DQK / 16; ++d0) { \
        const bf16x8 a0 = *(const LAS bf16x8*)(kb_ + 32 * d0), a1 = *(const LAS bf16x8*)(kb_ + 32 * KS + 32 * d0); \
        if (d0 == 0) { P0 = __builtin_amdgcn_mfma_f32_32x32x16_bf16(a0, qf[0], CI, 0, 0, 0); P1 = __builtin_amdgcn_mfma_f32_32x32x16_bf16(a1, qf[0], CI, 0, 0, 0); } \
        else { P0 = __builtin_amdgcn_mfma_f32_32x32x16_bf16(a0, qf[d0], P0, 0, 0, 0); P1 = __builtin_amdgcn_mfma_f32_32x32x16_bf16(a1, qf[d0], P1, 0, 0, 0); } } } while (0)
#define SBAR() __builtin_amdgcn_sched_barrier(0)
#define FA_CHUNK(c, p0, p1) do { \
    if ((c) < 4) { ma = max3f(ma, p0[4 * (c)], p0[4 * (c) + 1]); mb = max3f(mb, p0[4 * (c) + 2], p0[4 * (c) + 3]); ma = max3f(ma, p1[4 * (c)], p1[4 * (c) + 1]); mb = max3f(mb, p1[4 * (c) + 2], p1[4 * (c) + 3]); } \
    else if ((c) == 4) { float rm = max2f(ma, mb); { auto rr_ = __builtin_amdgcn_permlane32_swap(__float_as_uint(rm), __float_as_uint(rm), false, false); rm = max2f(__uint_as_float(rr_[0]), __uint_as_float(rr_[1])); } \
        if (NEGM) {   \
            const bool need_ = __any(rm > 5.0f || rm < -40.0f); pendf = need_; pend = 0.f; alpha = 1.f; \
            if (need_) { const float dl_ = (rm > 0.f || rm < -40.0f) ? rm : 0.f; _Pragma("unroll") for (int r_ = 0; r_ < 16; ++r_) { p0[r_] -= dl_; p1[r_] -= dl_; } \
                alpha = __builtin_amdgcn_exp2f(-dl_); mrun += dl_; pend = dl_; } } \
        else { rm += ctile;   \
        const bool need_ = __any(rm > mrun + 5.0f); const float mnew = need_ ? max2f(mrun, rm) : mrun; const float muse = (mnew == -INFINITY) ? 0.f : mnew; alpha = __builtin_amdgcn_exp2f(mrun - muse); mrun = mnew; msub = muse - ctile; } } \
    else if ((c) < 9) { _Pragma("unroll") for (int e_ = 0; e_ < 4; ++e_) p0[4 * ((c) - 5) + e_] = NEGM ? __builtin_amdgcn_exp2f(p0[4 * ((c) - 5) + e_]) : __builtin_amdgcn_exp2f(p0[4 * ((c) - 5) + e_] - msub); \
        asm volatile("" : "+v"(p0[4 * ((c) - 5)]), "+v"(p0[4 * ((c) - 5) + 1]), "+v"(p0[4 * ((c) - 5) + 2]), "+v"(p0[4 * ((c) - 5) + 3])); } \
    else { _Pragma("unroll") for (int e_ = 0; e_ < 4; ++e_) p1[4 * ((c) - 9) + e_] = NEGM ? __builtin_amdgcn_exp2f(p1[4 * ((c) - 9) + e_]) : __builtin_amdgcn_exp2f(p1[4 * ((c) - 9) + e_] - msub); \
        asm volatile("" : "+v"(p1[4 * ((c) - 9)]), "+v"(p1[4 * ((c) - 9) + 1]), "+v"(p1[4 * ((c) - 9) + 2]), "+v"(p1[4 * ((c) - 9) + 3])); } } while (0)
#define FA_GAP(g, p0, p1) do { if ((g) + 1 <= 8) FA_CHUNK((g) + 1, p0, p1); SBAR(); } while (0)
#define FA_KFRAG(d) (*(const LAS bf16x8*)(kb_ + 32 * (d))), (*(const LAS bf16x8*)(kb_ + 32 * KS + 32 * (d)))
#define FA_STEP(p0, p1, SN0, SN1, t) do { const int tt_ = (t) - kt_lo; float ctile = 0.f; \
    if (MODE == 2) { const int tlo = 64 * (t); \
        if (tlo + 63 - qw0 <= -128) { if (!NEGM) ctile = lut[0]; } else if (tlo - (qw0 + 31) >= 128) { if (!NEGM) ctile = lut[511]; } \
        else { const LAS float* lq_ = lut + (tlo + 4 * h - qpos + 256); _Pragma("unroll") for (int r = 0; r < 16; ++r) { p0[r] += lq_[(r & 3) + 8 * (r >> 2)]; p1[r] += lq_[(r & 3) + 8 * (r >> 2) + 32]; } } } \
    if (MODE == 1) { const LAS float* lp_ = lut + (64 * (t) + 4 * h - qpos + 320); \
        _Pragma("unroll") for (int r = 0; r < 16; ++r) { p0[r] += lp_[(r & 3) + 8 * (r >> 2)]; p1[r] += lp_[(r & 3) + 8 * (r >> 2) + 32]; } } \
    if (NEGM) { if (pendf) { _Pragma("unroll") for (int r_ = 0; r_ < 16; ++r_) { p0[r_] -= pend; p1[r_] -= pend; } } \
        float cn_ = 0.f; if (MODE == 2) { const int tl1 = 64 * ((t) + 1); if (tl1 + 63 - qw0 <= -128) cn_ = lut[0]; else if (tl1 - (qw0 + 31) >= 128) cn_ = lut[511]; } \
        const float cb_ = cn_ - mrun; if (__any(cb_ != cbs)) { cbs = cb_; _Pragma("unroll") for (int r_ = 0; r_ < 16; ++r_) negc[r_] = cb_; } } \
    SBAR(); \
      \
    float ma = -INFINITY, mb = -INFINITY, alpha = 1.f, msub = 0.f; \
    bf16x8 vfr[4][NDB]; const LAS unsigned char* vbs_ = Vl + (RES ? ((t) - win_lo) : (tt_ & 1)) * VBUF + vlane; \
    { const LAS unsigned char* kb_ = Kl + (RES ? (min((t) + 1, kt_hi - 1) - win_lo) : ((tt_ + 1) & 1)) * KBUF + r32 * KS + 16 * h; \
      bf16x8 kf[DQK / 16][2]; \
      kf[0][0] = *(const LAS bf16x8*)(kb_); kf[0][1] = *(const LAS bf16x8*)(kb_ + 32 * KS); kf[1][0] = *(const LAS bf16x8*)(kb_ + 32); kf[1][1] = *(const LAS bf16x8*)(kb_ + 32 * KS + 32); \
      if (KD > 2) { kf[2][0] = *(const LAS bf16x8*)(kb_ + 64); kf[2][1] = *(const LAS bf16x8*)(kb_ + 32 * KS + 64); } \
      if (!RES) { FA_LOADK(min((t) + 2, kt_hi - 1)); FA_LOADV(min((t) + 1, kt_hi - 1)); } \
      FA_CHUNK(0, p0, p1); SBAR(); \
      _Pragma("unroll") for (int d0 = 0; d0 < DQK / 16; ++d0) { \
        if (d0 + KD < DQK / 16) { kf[d0 + KD][0] = *(const LAS bf16x8*)(kb_ + 32 * (d0 + KD)); kf[d0 + KD][1] = *(const LAS bf16x8*)(kb_ + 32 * KS + 32 * (d0 + KD)); } \
        if (VPRE && (d0 == 1 || d0 == 2)) { _Pragma("unroll") for (int db = 0; db < NDB; ++db) { const LAS unsigned char* vp = vbs_ + db * 4096 + (d0 - 1) * 1024; \
            const v4i16_t lo = __builtin_amdgcn_ds_read_tr16_b64_v4i16((LAS v4i16_t*)vp); const v4i16_t hi = __builtin_amdgcn_ds_read_tr16_b64_v4i16((LAS v4i16_t*)(vp + 512)); \
            vfr[d0 - 1][db] = (bf16x8){lo[0], lo[1], lo[2], lo[3], hi[0], hi[1], hi[2], hi[3]}; } } \
        if (d0 == 0) SN0 = __builtin_amdgcn_mfma_f32_32x32x16_bf16(kf[0][0], qf[0], NEGM ? negc : zero16, 0, 0, 0); else SN0 = __builtin_amdgcn_mfma_f32_32x32x16_bf16(kf[d0][0], qf[d0], SN0, 0, 0, 0); \
        FA_GAP(2 * d0, p0, p1); \
        if (d0 == 0) SN1 = __builtin_amdgcn_mfma_f32_32x32x16_bf16(kf[0][1], qf[0], NEGM ? negc : zero16, 0, 0, 0); else SN1 = __builtin_amdgcn_mfma_f32_32x32x16_bf16(kf[d0][1], qf[d0], SN1, 0, 0, 0); \
        FA_GAP(2 * d0 + 1, p0, p1); } } \
    if (!__all(alpha == 1.0f)) { _Pragma("unroll") for (int db = 0; db < NDB; ++db) _Pragma("unroll") for (int r = 0; r < 16; ++r) o[db][r] *= alpha; } \
    SBAR(); \
      \
    { f32x16 lacc; u32x4 pw, pwn; \
      pw.x = pk2(p0[0], p0[1]); pw.y = pk2(p0[2], p0[3]); pw.z = pk2(p0[4], p0[5]); pw.w = pk2(p0[6], p0[7]); pwn = pw; \
      if (!VPRE) { _Pragma("unroll") for (int s_ = 0; s_ < 2; ++s_) _Pragma("unroll") for (int db = 0; db < NDB; ++db) { const LAS unsigned char* vp = vbs_ + db * 4096 + s_ * 1024; \
            const v4i16_t lo = __builtin_amdgcn_ds_read_tr16_b64_v4i16((LAS v4i16_t*)vp); const v4i16_t hi = __builtin_amdgcn_ds_read_tr16_b64_v4i16((LAS v4i16_t*)(vp + 512)); \
            vfr[s_][db] = (bf16x8){lo[0], lo[1], lo[2], lo[3], hi[0], hi[1], hi[2], hi[3]}; } } \
      SBAR(); \
      _Pragma("unroll") for (int s4 = 0; s4 < 4; ++s4) { \
        const bf16x8 pb = __builtin_bit_cast(bf16x8, pw); \
        lacc = __builtin_amdgcn_mfma_f32_32x32x16_bf16(ones, pb, (s4 == 0) ? zero16 : lacc, 0, 0, 0); \
        if (s4 == 0) { pwn.x = pk2(p0[8], p0[9]); pwn.y = pk2(p0[10], p0[11]); pwn.z = pk2(p0[12], p0[13]); pwn.w = pk2(p0[14], p0[15]); } \
        if (s4 == 1) { pwn.x = pk2(p1[0], p1[1]); pwn.y = pk2(p1[2], p1[3]); pwn.z = pk2(p1[4], p1[5]); pwn.w = pk2(p1[6], p1[7]); } \
        if (s4 == 2) { pwn.x = pk2(p1[8], p1[9]); pwn.y = pk2(p1[10], p1[11]); pwn.z = pk2(p1[12], p1[13]); pwn.w = pk2(p1[14], p1[15]); } \
        SBAR(); \
        _Pragma("unroll") for (int db = 0; db < NDB; ++db) { \
            o[db] = __builtin_amdgcn_mfma_f32_32x32x16_bf16(vfr[s4][db], pb, o[db], 0, 0, 0); \
            if (s4 < 2) { const LAS unsigned char* vp = vbs_ + db * 4096 + (s4 + 2) * 1024; \
                const v4i16_t lo = __builtin_amdgcn_ds_read_tr16_b64_v4i16((LAS v4i16_t*)vp); const v4i16_t hi = __builtin_amdgcn_ds_read_tr16_b64_v4i16((LAS v4i16_t*)(vp + 512)); \
                vfr[s4 + 2][db] = (bf16x8){lo[0], lo[1], lo[2], lo[3], hi[0], hi[1], hi[2], hi[3]}; } \
            if (s4 < 2 && db >= NDB - 2) FA_CHUNK(9 + 2 * s4 + (db - (NDB - 2)), p0, p1); \
            SBAR(); } \
        pw = pwn; } \
      lrun = lrun * alpha + lacc[0]; } \
    if (!RES) { FA_STOREK(tt_ & 1); FA_STOREV((tt_ + 1) & 1); __syncthreads(); } } while (0)
    const int vlane = (4 * h + ((lane & 15) >> 2)) * 64 + ((lane >> 4) & 1) * 32 + (lane & 3) * 8;
    f32x16 zero16;
#pragma unroll
    for (int r = 0; r < 16; ++r) zero16[r] = 0.f;
    f32x16 pA0 = zero16, pA1 = zero16, pB0 = zero16, pB1 = zero16;
    constexpr bool VPRE = (DV <= 64); constexpr int KD = (DV <= 64) ? 3 : 2;
    constexpr bool NEGM = (MODE != 1);
    f32x16 negc = zero16; float cbs = 0.f, pend = 0.f; bool pendf = false;
    if (NEGM) mrun = 0.f;
    if (!RES) {
        FA_LOADK(kt_lo); FA_LOADV(kt_lo); FA_STOREK(0); FA_STOREV(0);
        FA_LOADK(kt_lo + 1);
        __syncthreads();
        if (NEGM) { if (MODE == 2) {     const int tl0 = 64 * kt_lo; float c0_ = 0.f; if (tl0 + 63 - qw0 <= -128) c0_ = lut[0]; else if (tl0 - (qw0 + 31) >= 128) c0_ = lut[511]; cbs = c0_;
#pragma unroll
        for (int r_ = 0; r_ < 16; ++r_) negc[r_] = c0_; } }
        FA_QK(pA0, pA1, 0, negc);
        FA_STOREK(1);
        __syncthreads();
    } else {
        FA_QK(pA0, pA1, kt_lo - win_lo, zero16);
    }
    for (int kt = kt_lo; kt < kt_hi; kt += 2) {
        FA_STEP(pA0, pA1, pB0, pB1, kt);
        FA_STEP(pB0, pB1, pA0, pA1, kt + 1);
    }
#undef SBAR
#undef FA_CHUNK
#undef FA_KFRAG
#undef FA_GAP
#undef FA_LOADK
#undef FA_LOADV
#undef FA_STOREK
#undef FA_STOREV
#undef FA_QK
#undef FA_STEP
    float lt = lrun;
    if (MODE == 1) lt += __builtin_amdgcn_exp2f(sink2 - mrun);
    const float inv = 1.f / lt;
#pragma unroll
    for (int db = 0; db < NDB; ++db)
#pragma unroll
        for (int r = 0; r < 16; ++r) o[db][r] *= inv;
}

template <int DV, bool ACCUM>
__device__ __forceinline__ void attn_store(const f32x16 (&o)[DV / 32], const bf16_t* gate_row, bf16_t* merged_row, int h) {
#pragma unroll
    for (int db = 0; db < DV / 32; ++db)
#pragma unroll
        for (int rg = 0; rg < 4; ++rg) {
            const int d = 32 * db + 8 * rg + 4 * h;
            const u32x2 g = *(const u32x2*)(gate_row + d);
            float v0 = o[db][4 * rg + 0] * bflo(g.x), v1 = o[db][4 * rg + 1] * bfhi(g.x), v2 = o[db][4 * rg + 2] * bflo(g.y), v3 = o[db][4 * rg + 3] * bfhi(g.y);
            if (ACCUM) { const u32x2 mm = *(const u32x2*)(merged_row + d); v0 += bflo(mm.x); v1 += bfhi(mm.x); v2 += bflo(mm.y); v3 += bfhi(mm.y); }
            u32x2 w; w.x = pk2(v0, v1); w.y = pk2(v2, v3);
            *(u32x2*)(merged_row + d) = w;
            if (rg == 3) __builtin_amdgcn_sched_barrier(0);
        }
}

__device__ __forceinline__ void build_lut(LAS float* lut, const float* rel_table, int col, int wave_s) {
    const int tid = fresh_tid(wave_s);
    if (tid < 257) {
        const int rel = tid - 128, n = rel < 0 ? -rel : rel, base = rel > 0 ? 16 : 0; int bkt;
        if (n < 8) bkt = n; else { const unsigned t = (unsigned)(n * n) >> 6; const int k = 31 - __clz((int)t); bkt = min(8 + k, 15); }
        lut[tid] = rel_table[(base + bkt) * 24 + col] * LOG2E;
    }
}

__device__ __forceinline__ void build_lut_dense(LAS float* lut, const float* rel_table, int col, int wave_s) {
    const int tid = fresh_tid(wave_s);
    { const int rel = tid - 256, n = rel < 0 ? -rel : rel, base = rel > 0 ? 16 : 0; int bkt;
      if (n < 8) bkt = n; else { const unsigned t = (unsigned)(n * n) >> 6; const int k = 31 - __clz((int)t); bkt = min(8 + k, 15); }
      lut[tid] = rel_table[(base + bkt) * 24 + col] * LOG2E; }
}

__device__ __forceinline__ void build_lut_pad(LAS float* lut, const float* rel_table, int col, int wave_s) {
    const int tid = fresh_tid(wave_s);
    for (int i = tid; i < 640; i += 512) {
        const int rel = i - 320, n = rel < 0 ? -rel : rel, base = rel > 0 ? 16 : 0; int bkt;
        if (n < 8) bkt = n; else { const unsigned t = (unsigned)(n * n) >> 6; const int k = 31 - __clz((int)t); bkt = min(8 + k, 15); }
        lut[i] = (n <= 128) ? rel_table[(base + bkt) * 24 + col] * LOG2E : -INFINITY;
    }
}

typedef unsigned gu32_t;
#define RLX_AGENT __ATOMIC_RELAXED, __HIP_MEMORY_SCOPE_AGENT
#define XB_TMO      128
#define XB_XCNT(j)  (256  + 64 * (j))
#define XB_XSUB(j)  (1280 + 64 * (j))
#define XB_XGEN(j)  (2304 + 64 * (j))
#define XB_TOP      3328
#define XB_TOPGEN   3392
#define XCD_BAR_WORDS 3456
#define XB_SPIN_CAP (1u << 18)

__device__ __forceinline__ unsigned xb_ld(unsigned* p)              { return __hip_atomic_load(p, __ATOMIC_RELAXED, __HIP_MEMORY_SCOPE_AGENT); }
__device__ __forceinline__ unsigned xb_add(unsigned* p, unsigned v) { return __hip_atomic_fetch_add(p, v, __ATOMIC_RELAXED, __HIP_MEMORY_SCOPE_AGENT); }
__device__ __forceinline__ unsigned xb_xcc_id() { return (unsigned)__builtin_amdgcn_s_getreg((3 << 11) | 20) & 0xFu; }
#define XB_SPIN(cond, bar) do { unsigned _sp = 0; while (cond) { __builtin_amdgcn_s_sleep(1); \
    if ((++_sp & 255u) == 0u) { if (xb_ld(&(bar)[XB_TMO])) break; if (_sp > XB_SPIN_CAP) { atomicAdd(&(bar)[XB_TMO], 1u); break; } } } } while (0)

struct XcdBarrier {
    unsigned* bar; unsigned x;
    volatile LAS unsigned* st;
};

__device__ __forceinline__ XcdBarrier xcd_barrier_post(unsigned* bar, volatile LAS unsigned* st) {
    XcdBarrier b; b.bar = bar; b.x = xb_xcc_id(); b.st = st;
    if (threadIdx.x == 0) (void)xb_add(&bar[XB_XCNT(b.x)], 1u);
    return b;
}
__device__ __forceinline__ void xcd_barrier_complete(unsigned* bar, unsigned x, unsigned& nloc, unsigned& nx) {
    const unsigned G = gridDim.x * gridDim.y * gridDim.z;
    unsigned sum, cnt, mine, sp = 0u;
    for (;;) {
        sum = 0u; cnt = 0u; mine = 0u;
#pragma unroll
        for (unsigned j = 0; j < 16; ++j) { const unsigned c = xb_ld(&bar[XB_XCNT(j)]); sum += c; cnt += (c > 0u) ? 1u : 0u; mine = (j == x) ? c : mine; }
        if (sum == G) break;
        __builtin_amdgcn_s_sleep(1);
        if ((++sp & 255u) == 0u) { if (xb_ld(&bar[XB_TMO])) break; if (sp > XB_SPIN_CAP) { atomicAdd(&bar[XB_TMO], 1u); break; } }
    }
    nloc = mine > 0u ? mine : 1u; nx = cnt > 0u ? cnt : 1u;
}

__device__ __forceinline__ void xcd_barrier(const XcdBarrier& b) {
    asm volatile("s_waitcnt vmcnt(0)" ::: "memory");
    __syncthreads();
    if (threadIdx.x == 0) {
        unsigned* bar = b.bar;
        __builtin_amdgcn_s_waitcnt(0);
        unsigned nloc = b.st[0], nx = b.st[1];
        if (nloc == 0u) { xcd_barrier_complete(bar, b.x, nloc, nx); b.st[0] = nloc; b.st[1] = nx; }
        const unsigned old = xb_add(&bar[XB_XSUB(b.x)], 1u);
        const unsigned gen = old / nloc;
        if (old + 1u == (gen + 1u) * nloc) {
            __builtin_amdgcn_fence(__ATOMIC_RELEASE, "agent");
            asm volatile("s_waitcnt vmcnt(0)" ::: "memory");
            const unsigned og = xb_add(&bar[XB_TOP], 1u);
            const unsigned tg = og / nx;
            if (og + 1u == (tg + 1u) * nx) xb_add(&bar[XB_TOPGEN], 1u);
            else XB_SPIN(xb_ld(&bar[XB_TOPGEN]) == tg, bar);
            __builtin_amdgcn_fence(__ATOMIC_ACQUIRE, "agent");
            xb_add(&bar[XB_XGEN(b.x)], 1u);
            asm volatile("s_waitcnt vmcnt(0)" ::: "memory");
        } else {
            XB_SPIN(xb_ld(&bar[XB_XGEN(b.x)]) == gen, bar);
            __builtin_amdgcn_fence(__ATOMIC_ACQUIRE, "agent");
            asm volatile("s_waitcnt vmcnt(0)" ::: "memory");
        }
    }
    __syncthreads();
}


struct Args { const float* in[28]; float* out; unsigned char* ws; };

__device__ __forceinline__ void conv_item(const float* W, int K, int N, const float* gain, bf16_t* WT, int dst_row0, LAS float* scr, int kb, int n0, int lane) {
    const int k0 = 64 * kb;
    float v[32];
    const float* wp = W + (size_t)(k0 + (lane >> 5)) * N + n0 + (lane & 31);
#pragma unroll
    for (int i = 0; i < 32; ++i) v[i] = wp[(size_t)(2 * i) * N];
    if (gain) {
#pragma unroll
        for (int i = 0; i < 32; ++i) v[i] *= gain[k0 + 2 * i + (lane >> 5)];
    }
#pragma unroll
    for (int i = 0; i < 32; ++i) scr[(2 * i + (lane >> 5)) * 33 + (lane & 31)] = v[i];
    asm volatile("s_waitcnt lgkmcnt(0)" ::: "memory");
    const int c = lane & 7;
#pragma unroll
    for (int j = 0; j < 4; ++j) { const int n = (lane >> 3) + 8 * j; const LAS float* s = scr + (8 * c) * 33 + n;
        u32x4 o; o.x = pk2(s[0 * 33], s[1 * 33]); o.y = pk2(s[2 * 33], s[3 * 33]); o.z = pk2(s[4 * 33], s[5 * 33]); o.w = pk2(s[6 * 33], s[7 * 33]);
        *(u32x4*)(WT + (size_t)(dst_row0 + n) * K + k0 + 8 * c) = o; }
    asm volatile("s_waitcnt lgkmcnt(0)" ::: "memory");
}

__global__ void __launch_bounds__(512) fwd_megakernel(Args a) {
    extern __shared__ __attribute__((aligned(16))) unsigned char lds_raw[];
    LAS unsigned char* lds = (LAS unsigned char*)lds_raw;
    cg::grid_group grid = cg::this_grid();
#define GSYNC() do { asm volatile("s_waitcnt vmcnt(0) lgkmcnt(0)" ::: "memory"); __syncthreads(); grid.sync(); } while (0)
    { volatile LAS unsigned* st0 = (volatile LAS unsigned*)(lds + 147456 - 64); if (threadIdx.x < 16) st0[threadIdx.x] = 0u; }
    __syncthreads();
    const XcdBarrier xbar = xcd_barrier_post((unsigned*)(a.ws + WS_BAR), (volatile LAS unsigned*)(lds + 147456 - 64));
#define XSYNC() do { asm volatile("s_waitcnt vmcnt(0) lgkmcnt(0)" ::: "memory"); xcd_barrier(xbar); } while (0)
    const int wave_s = __builtin_amdgcn_readfirstlane(threadIdx.x >> 6);
    const int G = gridDim.x, bx = blockIdx.x, vcu = (G % 8 == 0) ? (bx % 8) * (G / 8) + bx / 8 : bx;
    const int NGW = G * 8;
#define FRESH_IDS const int tid = fresh_tid(wave_s); const int lane = tid & 63, wave = wave_s, gw = vcu * 8 + wave; (void)lane; (void)gw; (void)tid;
    unsigned char* ws = a.ws;
    float* PH0 = (float*)(ws + WS_PH0); float* PH1 = (float*)(ws + WS_PH1); float* PH2 = (float*)(ws + WS_PH2); float* PH3 = (float*)(ws + WS_PH3);
    float* PQ = (float*)(ws + WS_PQ); float* PKV = (float*)(ws + WS_PKV);
    float* rope = (float*)(ws + WS_ROPE);
    bf16_t* Wb = (bf16_t*)(ws + WS_W);
    bf16_t* PB = (bf16_t*)(ws + WS_PB);
    bf16_t* HB = (bf16_t*)(ws + WS_HB);
    bf16_t* ACT = (bf16_t*)(ws + WS_ACT);
    bf16_t* QA = (bf16_t*)(ws + WS_QA);
    bf16_t* KVA = (bf16_t*)(ws + WS_KVA);
    bf16_t* HID = (bf16_t*)(ws + WS_HID);
    bf16_t* PPJ = (bf16_t*)(ws + WS_PPJ);
    float* Hf = a.out;
    bf16_t* LOP = (bf16_t*)((unsigned char*)a.out + (size_t)128 * MiB);
    const float* rel_table = a.in[18];

    {
        FRESH_IDS
        const float* x = a.in[0];
        for (int m = gw; m < MTOK; m += NGW) {
            const f32x4* xr = (const f32x4*)(x + (size_t)m * DM) + lane; u32x2* l8 = (u32x2*)(LOP + (size_t)m * DM) + lane;
            u32x2* o8 = (u32x2*)(HB + (size_t)m * DM) + lane; float s = 0.f;
#pragma unroll
            for (int j = 0; j < 4; ++j) { const f32x4 v = xr[64 * j]; s += (v[0] * v[0] + v[1] * v[1]) + (v[2] * v[2] + v[3] * v[3]); u32x2 w; w.x = pk2(v[0], v[1]); w.y = pk2(v[2], v[3]); o8[64 * j] = w;
                u32x2 wl; wl.x = pk2(v[0] - bflo(w.x), v[1] - bfhi(w.x)); wl.y = pk2(v[2] - bflo(w.y), v[3] - bfhi(w.y)); l8[64 * j] = wl; }
            s = wave_sum(s); if (lane < 16) PH0[(size_t)m * 16 + lane] = (lane == 0) ? s : 0.f;
        }
        const int gt = gw * 64 + lane, NGT = NGW * 64;
        { u32x4* z = (u32x4*)(Wb + W_IN + (size_t)672 * DM); for (int i = gt; i < 96 * DM / 8; i += NGT) z[i] = (u32x4){0u, 0u, 0u, 0u}; }
        for (int i = gt; i < SEQ * 16; i += NGT) { const int pos = i >> 4, k = i & 15; const float inv = exp2f(-(float)k * 0.8304820237218406f); const float ang = (float)pos * inv;
            float r = ang * 0.15915494309189535f; r = r - floorf(r); rope[pos * 32 + k] = __builtin_amdgcn_cosf(r); rope[pos * 32 + 16 + k] = __builtin_amdgcn_sinf(r); }
    }

#pragma nounroll
    for (int L = 0; L < DEPTH; ++L) {
        {
            FRESH_IDS
            LAS float* scr = (LAS float*)(lds + wave * 16384);
            const float* g_ffn1 = a.in[2] + (size_t)L * DM; const float* g_mix = a.in[6] + (size_t)L * DM; const float* g_q = a.in[8] + (size_t)L * 384; const float* g_kv = a.in[10] + (size_t)L * 256;
            const float* g_ffn2 = a.in[20] + (size_t)L * DM; const float* g_ple = a.in[24] + (size_t)L * DM;
            const float* w_g1 = a.in[3] + (size_t)L * DM * DFF; const float* w_u1 = a.in[4] + (size_t)L * DM * DFF; const float* w_d1 = a.in[5] + (size_t)L * DFF * DM;
            const float* w_in = a.in[7] + (size_t)L * DM * INW; const float* w_uq = a.in[9] + (size_t)L * 384 * QAW; const float* w_ukv = a.in[11] + (size_t)L * 256 * KVAW;
            const float* w_out = a.in[19] + (size_t)L * DM * DM;
            const float* w_g2 = a.in[21] + (size_t)L * DM * DFF; const float* w_u2 = a.in[22] + (size_t)L * DM * DFF; const float* w_d2 = a.in[23] + (size_t)L * DFF * DM;
            const float* w_pg = a.in[25] + (size_t)L * DM * DM; const float* w_pp = a.in[26] + (size_t)L * PLE * DM;
            constexpr int I_G = 16 * 88, I_D = 44 * 32, I_IN = 16 * 261, I_UQ = 6 * 48, I_UKV = 4 * 64, I_SQ = 16 * 32, I_PP = 4 * 32;
            constexpr int NITEMS = 4 * I_G + 2 * I_D + I_IN + I_UQ + I_UKV + 2 * I_SQ + I_PP;
#define CONV_MAT(CNT, W_, K_, N_, G_, DST_, MAPEXPR) if (r < (CNT)) { const int nblk = (N_) / 32, kb = r / nblk, n0 = (r % nblk) * 32; conv_item(W_, K_, N_, G_, DST_, (MAPEXPR), scr, kb, n0, lane); continue; } r -= (CNT);
            for (int it = gw; it < NITEMS; it += NGW) {
                int r = it;
                CONV_MAT(I_G, w_g1, DM, DFF, g_ffn1, Wb + W_GU1, (n0 >> 7) * 256 + (n0 & 127))
                CONV_MAT(I_G, w_u1, DM, DFF, g_ffn1, Wb + W_GU1, (n0 >> 7) * 256 + 128 + (n0 & 127))
                CONV_MAT(I_D, w_d1, DFF, DM, (const float*)nullptr, Wb + W_D1, n0)
                CONV_MAT(I_IN, w_in, DM, INW, g_mix, Wb + W_IN, (n0 < 672 ? n0 : n0 + 96))
                CONV_MAT(I_UQ, w_uq, 384, QAW, g_q, Wb + W_UQ, n0)
                CONV_MAT(I_UKV, w_ukv, 256, KVAW, g_kv, Wb + W_UKV, n0)
                CONV_MAT(I_SQ, w_out, DM, DM, (const float*)nullptr, Wb + W_OUT, n0)
                CONV_MAT(I_G, w_g2, DM, DFF, g_ffn2, Wb + W_GU2, (n0 >> 7) * 256 + (n0 & 127))
                CONV_MAT(I_G, w_u2, DM, DFF, g_ffn2, Wb + W_GU2, (n0 >> 7) * 256 + 128 + (n0 & 127))
                CONV_MAT(I_D, w_d2, DFF, DM, (const float*)nullptr, Wb + W_D2, n0)
                CONV_MAT(I_SQ, w_pg, DM, DM, g_ple, Wb + W_PG, n0)
                CONV_MAT(I_PP, w_pp, PLE, DM, (const float*)nullptr, Wb + W_PP, n0)
            }
#undef CONV_MAT
            const int gt = gw * 64 + lane, NGT = NGW * 64;
            { const f32x4* ps = (const f32x4*)(a.in[1] + (size_t)L * MTOK * PLE); u32x4* pd = (u32x4*)PB;
              constexpr int PTOT = MTOK * PLE / 8; int i = gt;
              for (; i + NGT < PTOT; i += 2 * NGT) { const f32x4 a0 = ps[2 * i], a1 = ps[2 * i + 1], b0 = ps[2 * (i + NGT)], b1 = ps[2 * (i + NGT) + 1];
                  u32x4 wa, wb; wa.x = pk2(a0[0], a0[1]); wa.y = pk2(a0[2], a0[3]); wa.z = pk2(a1[0], a1[1]); wa.w = pk2(a1[2], a1[3]);
                  wb.x = pk2(b0[0], b0[1]); wb.y = pk2(b0[2], b0[3]); wb.z = pk2(b1[0], b1[1]); wb.w = pk2(b1[2], b1[3]); pd[i] = wa; pd[i + NGT] = wb; }
              if (i < PTOT) { const f32x4 v0 = ps[2 * i], v1 = ps[2 * i + 1]; u32x4 w; w.x = pk2(v0[0], v0[1]); w.y = pk2(v0[2], v0[3]); w.z = pk2(v1[0], v1[1]); w.w = pk2(v1[2], v1[3]); pd[i] = w; } }
        }
        GSYNC();

        float* ssq0 = PH0; float* ssq1 = PH1; float* ssq2 = PH2; float* ssq3 = PH3; float* ssq4 = PH0;

        { pg8::Gemm g{(L == 0) ? HB : (const bf16_t*)QA, Wb + W_GU1, MTOK, 2 * DFF, DM, DM}; pg8::StaticOrder S; S.init(MTOK, 2 * DFF, G, bx);
          pg8::EpiSwiglu E{HID, ssq0}; pg8::gemm_phase(lds, wave_s, g, S, E); }
        XSYNC();
        { pg8::Gemm g{HID, Wb + W_D1, MTOK, DM, DFF, DFF}; pg8::StaticOrder S; S.init(MTOK, DM, G, bx);
          pg8::EpiResid<false> E{(L == 0) ? HB : (const bf16_t*)QA, HB, LOP, ssq1, nullptr, nullptr, 0.5f, 0.f}; pg8::gemm_phase(lds, wave_s, g, S, E); }
        XSYNC();

#pragma nounroll
        for (int ck = 0; ck < NCHUNK; ++ck) {
            const size_t r0 = (size_t)ck * MC;
            { pg8::Gemm g{HB + r0 * DM, Wb + W_IN, MC, INP, DM, DM}; pg8::StaticOrder S; S.init(MC, INP, G, bx);
              pg8::EpiGen E{ACT, INP, ssq1 + r0 * 16, 1.f / 1024.f, 1, PQ, PKV, rope, 16, 4}; pg8::gemm_phase(lds, wave_s, g, S, E); }
            XSYNC();
            { pg8::Gemm g{ACT + C_CQ, Wb + W_UQ, MC, QAW, 384, INP}; pg8::StaticOrder S; S.init(MC, QAW, G, bx);
              pg8::EpiGen E{QA, QAW, PQ, 1.f / 384.f, 2, nullptr, nullptr, rope, 16, 3}; pg8::gemm_phase(lds, wave_s, g, S, E); }
            { pg8::Gemm g{ACT + C_CKV, Wb + W_UKV, MC, KVAW, 256, INP}; pg8::StaticOrder S; S.init(MC, KVAW, G, bx);
              pg8::EpiGen E{KVA, KVAW, PKV, 1.f / 256.f, 0, nullptr, nullptr, rope, 8, 2}; pg8::gemm_phase(lds, wave_s, g, S, E); }
            XSYNC();
            {
            FRESH_IDS
            for (int u = vcu; u < NB_CHUNK * 16 * 8; u += G) {
                const int qb = u & 7, hh = (u >> 3) & 15, b = u >> 7; const size_t tok0 = (size_t)b * SEQ;
                f32x16 o[2];
                flash_core<96, 64, 0>(lds, wave_s, QA + (tok0 + 256 * qb) * QAW + 96 * hh, QAW, KVA + tok0 * KVAW + 128 * hh, KVAW, ACT + tok0 * INP + C_KR, INP,
                                      KVA + tok0 * KVAW + 128 * hh + 64, KVAW, 256 * qb, 0, SEQ / 64, (const LAS float*)(lds + ATT_LUT_OFF), 0.f, o);
                const int l2 = fresh_tid(wave_s) & 63;
                bf16_t* row = ACT + (tok0 + 256 * qb + 32 * wave + (l2 & 31)) * INP + C_GA + 64 * hh;
                attn_store<64, false>(o, row, row, l2 >> 5);
            }
            }
            XSYNC();
            {
            FRESH_IDS
            constexpr int SW_KBUF = 64 * 144, SW_VBUF = 8192, SW_LUT = 8 * SW_KBUF + 8 * SW_VBUF;
            for (int u = vcu; u < NB_CHUNK * 4 * 8; u += G) {
                const int qb = u & 7, kvh = (u >> 3) & 3, b = u >> 5; const size_t tok0 = (size_t)b * SEQ;
                const int q0 = 256 * qb; const int klo = max(0, (q0 - 128) >> 6), khi = min(SEQ / 64, (q0 + 384) >> 6);
                __syncthreads();
                { const int t2 = fresh_tid(wave_s); const int key = t2 >> 3, c = t2 & 7;
                  const bf16_t* kp = ACT + (tok0 + 64 * klo + key) * INP + C_KB + 64 * kvh + 8 * c; const bf16_t* vp = ACT + (tok0 + 64 * klo + key) * INP + C_VB + 64 * kvh + 8 * c;
                  LAS unsigned char* kd = lds + key * 144 + 16 * c; LAS unsigned char* vd = lds + 8 * SW_KBUF + (c >> 2) * 4096 + (key >> 3) * 512 + (key & 7) * 64 + (c & 3) * 16;
                  for (int i = 0; i < khi - klo; i += 2) {
                      const u32x4 k0 = *(const u32x4*)(kp + (size_t)(64 * i) * INP), v0 = *(const u32x4*)(vp + (size_t)(64 * i) * INP);
                      const u32x4 k1 = *(const u32x4*)(kp + (size_t)(64 * (i + 1)) * INP), v1 = *(const u32x4*)(vp + (size_t)(64 * (i + 1)) * INP);
                      *(LAS u32x4*)(kd + i * SW_KBUF) = k0; *(LAS u32x4*)(vd + i * SW_VBUF) = v0; *(LAS u32x4*)(kd + (i + 1) * SW_KBUF) = k1; *(LAS u32x4*)(vd + (i + 1) * SW_VBUF) = v1; } }
                const int qw0 = q0 + 32 * wave; int wlo = max(klo, (qw0 - 128) >> 6), whi = min(khi, ((qw0 + 159) >> 6) + 1);
                if ((whi - wlo) & 1) { if (whi < khi) ++whi; else --wlo; }
#pragma nounroll
                for (int g = 0; g < 4; ++g) {
                    const int hh = 4 * kvh + g;
                    __syncthreads();
                    build_lut_pad((LAS float*)(lds + SW_LUT), rel_table, hh, wave_s);
                    __syncthreads();
                    const float sink2 = a.in[12][L * 16 + hh] * LOG2E;
                    f32x16 o[2];
                    flash_core<64, 64, 1, true>(lds, wave_s, ACT + (tok0 + q0) * INP + C_QB + 64 * hh, INP, nullptr, 0, nullptr, 0, nullptr, 0, q0, wlo, whi,
                                                (const LAS float*)(lds + SW_LUT), sink2, o, klo);
                    const int l2 = fresh_tid(wave_s) & 63;
                    bf16_t* row = ACT + (tok0 + q0 + 32 * wave + (l2 & 31)) * INP;
                    attn_store<64, true>(o, row + C_GB + 64 * hh, row + C_GA + 64 * hh, l2 >> 5);
                }
            }
            }
            XSYNC();
            {
                FRESH_IDS
                int Lv = L; asm volatile("" : "+s"(Lv));
                const unsigned lib = (Lv == 0) ? __float_as_uint(0.2f) : (Lv == 1) ? __float_as_uint(0.35550906759096926f) : (Lv == 2) ? __float_as_uint(0.47071301834358416f) : __float_as_uint(0.5560582041556405f);
                const unsigned omb = (Lv == 0) ? __float_as_uint(0.8f) : (Lv == 1) ? __float_as_uint(0.64449093240903074f) : (Lv == 2) ? __float_as_uint(0.52928698165641584f) : __float_as_uint(0.4439417958443595f);
                const float lambda_init = __uint_as_float(lib);
                float s1 = 0.f, s2 = 0.f;
                for (int k_ = 0; k_ < 64; ++k_) { s1 += a.in[13][Lv * 64 + k_] * a.in[14][Lv * 64 + k_]; s2 += a.in[15][Lv * 64 + k_] * a.in[16][Lv * 64 + k_]; }
                const float lam = uniformf(expf(s1) - expf(s2) + lambda_init);
                const float* subln = a.in[17] + Lv * 128;
                float* scr_blk = (float*)(ws + WS_SCR) + (size_t)bx * (64 * 512);
                for (int u = vcu; u < NB_CHUNK * 8 * 8; u += G) {
                    const int qb = u & 7, hh = (u >> 3) & 7, b = u >> 6; const size_t tok0 = (size_t)b * SEQ; const int q0 = 256 * qb;
                    LAS float* lut = (LAS float*)(lds + ATT_LUT_OFF);
                    build_lut_dense(lut, rel_table, 16 + hh, wave_s);
                    { int Lw = Lv; asm volatile("" : "+s"(Lw));
                      const unsigned ob_ = (Lw == 0) ? __float_as_uint(0.8f) : (Lw == 1) ? __float_as_uint(0.64449093240903074f) : (Lw == 2) ? __float_as_uint(0.52928698165641584f) : __float_as_uint(0.4439417958443595f);
                      if (lane_id() == 0) ((LAS unsigned*)lut)[520] = ob_; }
                    f32x16 o[4];
                    flash_core<64, 128, 2>(lds, wave_s, ACT + (tok0 + q0) * INP + C_QC + 128 * hh, INP, ACT + tok0 * INP + C_KC + 128 * hh, INP, nullptr, 0,
                                           ACT + tok0 * INP + C_VC + 128 * hh, INP, q0, 0, SEQ / 64, lut, 0.f, o);
                    { f32x4* scr = (f32x4*)(scr_blk + (size_t)fresh_tid(wave_s) * 64);
#pragma unroll
                    for (int db = 0; db < 4; ++db)
#pragma unroll
                        for (int j = 0; j < 4; ++j) scr[db * 4 + j] = (f32x4){o[db][4 * j], o[db][4 * j + 1], o[db][4 * j + 2], o[db][4 * j + 3]}; }
                    flash_core<64, 128, 2>(lds, wave_s, ACT + (tok0 + q0) * INP + C_QC + 128 * hh + 64, INP, ACT + tok0 * INP + C_KC + 128 * hh + 64, INP, nullptr, 0,
                                           ACT + tok0 * INP + C_VC + 128 * hh, INP, q0, 0, SEQ / 64, lut, 0.f, o);
                    float ss = 0.f;
                    const int t3 = fresh_tid(wave_s), l3 = t3 & 63;
                    const f32x4* scr = (const f32x4*)(scr_blk + (size_t)t3 * 64);
#pragma unroll
                    for (int db = 0; db < 4; ++db)
                    {
#pragma unroll
                      for (int j = 0; j < 4; ++j) { const f32x4 t4 = scr[db * 4 + j];
#pragma unroll
                            for (int e = 0; e < 4; ++e) { const float v = t4[e] - lam * o[db][4 * j + e]; o[db][4 * j + e] = v; ss += v * v; } }
                      __builtin_amdgcn_sched_barrier(0); }
                    ss += __shfl_xor(ss, 32);
                    const float rs = rsqrtf(ss * (1.f / 128.f) + EPS) * lut[520];
                    const int hl = l3 >> 5;
#pragma unroll
                    for (int db = 0; db < 4; ++db)
                    {
#pragma unroll
                      for (int rg = 0; rg < 4; ++rg) { const f32x4 gn = *(const f32x4*)(subln + 32 * db + 8 * rg + 4 * hl);
#pragma unroll
                            for (int e = 0; e < 4; ++e) o[db][4 * rg + e] *= rs * gn[e]; }
                      __builtin_amdgcn_sched_barrier(0); }
                    bf16_t* row = ACT + (tok0 + q0 + 32 * wave + (l3 & 31)) * INP;
                    attn_store<128, true>(o, row + C_GC + 128 * hh, row + C_GA + 128 * hh, hl);
                }
            }
            XSYNC();
            { pg8::Gemm g{ACT + C_GA, Wb + W_OUT, MC, DM, DM, INP}; pg8::StaticOrder S; S.init(MC, DM, G, bx);
              pg8::EpiResid<false> E{HB + r0 * DM, HB + r0 * DM, LOP + r0 * DM, ssq2 + r0 * 16, nullptr, nullptr, 1.0f, 0.f}; pg8::gemm_phase(lds, wave_s, g, S, E); }
            XSYNC();
        }
        { pg8::Gemm g{HB, Wb + W_GU2, MTOK, 2 * DFF, DM, DM}; pg8::StaticOrder S; S.init(MTOK, 2 * DFF, G, bx);
          pg8::EpiSwiglu E{HID, ssq2}; pg8::gemm_phase(lds, wave_s, g, S, E); }
        { pg8::Gemm g{PB, Wb + W_PP, MTOK, DM, PLE, PLE}; pg8::StaticOrder S; S.init(MTOK, DM, G, bx);
          pg8::EpiGen E{PPJ, DM, nullptr, 0.f, 0, nullptr, nullptr, rope, 16, 0}; pg8::gemm_phase(lds, wave_s, g, S, E); }
        XSYNC();
        { pg8::Gemm g{HID, Wb + W_D2, MTOK, DM, DFF, DFF}; pg8::StaticOrder S; S.init(MTOK, DM, G, bx);
          pg8::EpiResid<false> E{HB, HB, LOP, ssq3, nullptr, nullptr, 0.5f, 0.f}; pg8::gemm_phase(lds, wave_s, g, S, E); }
        XSYNC();
        { pg8::Gemm g{HB, Wb + W_PG, MTOK, DM, DM, DM}; pg8::StaticOrder S; S.init(MTOK, DM, G, bx);
          pg8::EpiResid<true> E{HB, QA, LOP, ssq4, ssq3, PPJ, 1.0f, 0.f}; pg8::gemm_phase(lds, wave_s, g, S, E); }
        XSYNC();
    }
    {
        FRESH_IDS
        const float* fg = a.in[27]; const float* ssqf = PH0;
        bf16_t* LOC = ACT;
#pragma nounroll
        for (int stage = 0; stage < 2; ++stage) {
            const int mbeg = stage * (MTOK / 2);
            const bf16_t* lsrc = stage ? (LOC - (size_t)(MTOK / 2) * DM) : LOP;
            for (int m = mbeg + gw; m < mbeg + MTOK / 2; m += NGW) {
                f32x4* hr = (f32x4*)(Hf + (size_t)m * DM) + lane; const u32x2* hb = (const u32x2*)(QA + (size_t)m * DM) + lane; const u32x2* lb = (const u32x2*)(lsrc + (size_t)m * DM) + lane;
                const f32x4* pp_ = (const f32x4*)(ssqf + (size_t)m * 16); const f32x4 q0_ = pp_[0], q1_ = pp_[1], q2_ = pp_[2], q3_ = pp_[3];
                const float tot_ = (((q0_[0] + q0_[1]) + (q0_[2] + q0_[3])) + ((q1_[0] + q1_[1]) + (q1_[2] + q1_[3]))) + (((q2_[0] + q2_[1]) + (q2_[2] + q2_[3])) + ((q3_[0] + q3_[1]) + (q3_[2] + q3_[3])));
                const float rs = rsqrtf(tot_ * (1.f / 1024.f) + EPS);
#pragma unroll
                for (int j = 0; j < 4; ++j) { const f32x4 gn = *((const f32x4*)fg + lane + 64 * j); const u32x2 wh = hb[64 * j], wl = lb[64 * j];
                    f32x4 v = (f32x4){bflo(wh.x) + bflo(wl.x), bfhi(wh.x) + bfhi(wl.x), bflo(wh.y) + bflo(wl.y), bfhi(wh.y) + bfhi(wl.y)}; v = v * rs * gn; hr[64 * j] = v; }
            }
            if (stage == 0) {
                const u32x4* src = (const u32x4*)(LOP + (size_t)(MTOK / 2) * DM); u32x4* dst = (u32x4*)LOC;
                const int gt = gw * 64 + lane, NGT = NGW * 64;
                for (int i = gt; i < (MTOK / 2) * DM / 8; i += NGT) dst[i] = src[i];
                XSYNC();
            }
        }
    }
}

constexpr int LDS_BYTES = 147456;

extern "C" void kernel_launch(void* const* d_in, const int* in_sizes, int n_in, void* d_out, int out_size, void* d_ws, size_t ws_size, hipStream_t stream) {
    static int grid = 0;
    if (grid == 0) {
        if (n_in != 28 || out_size != MTOK * DM || ws_size < WS_END) { fprintf(stderr, "kernel_launch: unexpected shapes (n_in %d out %d ws %zu)\n", n_in, out_size, ws_size); grid = -1; return; }
        int dev = 0, cus = 0, per_cu = 0;
        hipGetDevice(&dev);
        hipDeviceGetAttribute(&cus, hipDeviceAttributeMultiprocessorCount, dev);
        hipFuncSetAttribute((const void*)fwd_megakernel, hipFuncAttributeMaxDynamicSharedMemorySize, LDS_BYTES);
        hipOccupancyMaxActiveBlocksPerMultiprocessor(&per_cu, (const void*)fwd_megakernel, 512, LDS_BYTES);
        if (per_cu < 1) per_cu = 1;
        if (per_cu > 1) per_cu = 1;
        grid = cus * per_cu;
        if (grid > 256) grid = 256;
        (void)hipGetLastError();
    }
    if (grid < 0) return;
    Args a{};
    for (int i = 0; i < 28; ++i) a.in[i] = (const float*)d_in[i];
    a.out = (float*)d_out; a.ws = (unsigned char*)d_ws;
    (void)hipMemsetAsync((char*)d_ws + WS_BAR, 0, 16384, stream);
    void* kargs[] = {&a};
    hipError_t e = hipLaunchCooperativeKernel((const void*)fwd_megakernel, dim3(grid), dim3(512), kargs, LDS_BYTES, stream);
    if (e != hipSuccess) fprintf(stderr, "cooperative launch failed: %s (grid %d)\n", hipGetErrorString(e), grid);
}
```

```cpp
#include <hip/hip_runtime.h>
#include <hip/hip_cooperative_groups.h>
#include <cstdio>
#include <cstdint>
#include <cmath>
namespace cg = cooperative_groups;

#define LAS __attribute__((address_space(3)))
typedef unsigned short bf16_t;
typedef short bf16x8 __attribute__((ext_vector_type(8)));
typedef float f32x4 __attribute__((ext_vector_type(4)));
typedef float f32x16 __attribute__((ext_vector_type(16)));
typedef unsigned u32x4 __attribute__((ext_vector_type(4)));
typedef unsigned u32x2 __attribute__((ext_vector_type(2)));
typedef short v4i16_t __attribute__((ext_vector_type(4)));
typedef float f32x2_t __attribute__((ext_vector_type(2)));
typedef __bf16 bf16x2_t __attribute__((ext_vector_type(2)));

constexpr int DM = 1024, SEQ = 2048, DEPTH = 4, MTOK = 65536, DFF = 2816, PLE = 256;
constexpr int NB_CHUNK = 16, MC = NB_CHUNK * SEQ, NCHUNK = 2;
constexpr int INW = 8352, INP = 8448;
constexpr int C_CQ = 0, C_CKV = 384, C_KR = 640, C_QB = 768, C_KB = 1792, C_VB = 2048, C_QC = 2304, C_KC = 3328, C_VC = 4352, C_GA = 5376, C_GB = 6400, C_GC = 7424;
constexpr int QAW = 1536, KVAW = 2048;
constexpr float EPS = 1e-6f;
constexpr float LOG2E = 1.4426950408889634f;
constexpr float C2_64 = 0.125f * 1.4426950408889634f;
constexpr float C2_96 = 0.10206207261596577f * 1.4426950408889634f;

constexpr size_t MiB = 1u << 20;
constexpr size_t WS_PH0 = 0, WS_PQ = 4 * MiB, WS_PKV = 6 * MiB;
constexpr size_t WS_PH1 = 1012 * MiB, WS_PH2 = 1016 * MiB, WS_PH3 = 1020 * MiB;
constexpr size_t WS_ROPE = 7 * MiB;
constexpr size_t WS_BAR = 7 * MiB + 512 * 1024;
constexpr size_t WS_W = 8 * MiB;
constexpr size_t WS_PB = 66 * MiB;
constexpr size_t WS_HB = 98 * MiB;
constexpr size_t WS_ACT = 226 * MiB;
constexpr size_t WS_QA = 754 * MiB;
constexpr size_t WS_KVA = 850 * MiB;
constexpr size_t WS_HID = 226 * MiB;
constexpr size_t WS_PPJ = 578 * MiB;
constexpr size_t WS_SCR = 980 * MiB;
constexpr size_t WS_END = 1024 * MiB;
constexpr size_t W_GU1 = 0, W_D1 = W_GU1 + (size_t)2 * DFF * DM, W_IN = W_D1 + (size_t)DM * DFF, W_UQ = W_IN + (size_t)INP * DM,
                 W_UKV = W_UQ + (size_t)QAW * 384, W_OUT = W_UKV + (size_t)KVAW * 256, W_GU2 = W_OUT + (size_t)DM * DM,
                 W_D2 = W_GU2 + (size_t)2 * DFF * DM, W_PG = W_D2 + (size_t)DM * DFF, W_PP = W_PG + (size_t)DM * DM, W_ENDE = W_PP + (size_t)DM * PLE;
static_assert(W_ENDE * 2 <= 58 * MiB, "weights fit");

__device__ __forceinline__ unsigned pk2(float lo, float hi) { f32x2_t v = {lo, hi}; bf16x2_t b = __builtin_convertvector(v, bf16x2_t); return __builtin_bit_cast(unsigned, b); }
__device__ __forceinline__ float bflo(unsigned u) { return __uint_as_float(u << 16); }
__device__ __forceinline__ float bfhi(unsigned u) { return __uint_as_float(u & 0xffff0000u); }
__device__ __forceinline__ float wave_sum(float v) {
#pragma unroll
    for (int o = 1; o < 64; o <<= 1) v += __shfl_xor(v, o);
    return v;
}
__device__ __forceinline__ float max3f(float a, float b, float c) { float r; asm("v_max3_f32 %0, %1, %2, %3" : "=v"(r) : "v"(a), "v"(b), "v"(c)); return r; }
__device__ __forceinline__ float max2f(float a, float b) { float r; asm("v_max_f32_e32 %0, %1, %2" : "=v"(r) : "v"(a), "v"(b)); return r; }
__device__ __forceinline__ float fast_sigmoid(float x) { return __builtin_amdgcn_rcpf(1.f + __expf(-x)); }
__device__ __forceinline__ int lane_id() { int r; asm volatile("v_mbcnt_lo_u32_b32 %0, -1, 0\n\tv_mbcnt_hi_u32_b32 %0, -1, %0" : "=&v"(r)); return r; }
__device__ __forceinline__ int fresh_tid(int wave_s) { return wave_s * 64 + lane_id(); }
__device__ __forceinline__ float uniformf(float v) { return __uint_as_float(__builtin_amdgcn_readfirstlane(__float_as_uint(v))); }
__device__ __forceinline__ void atomic_addf(float* p, float v) { __hip_atomic_fetch_add(p, v, __ATOMIC_RELAXED, __HIP_MEMORY_SCOPE_AGENT); }

__device__ __forceinline__ float row_ssq(const float* part, int pitch, int n4, int row, int fq) {
    f32x4 v = (f32x4){0.f, 0.f, 0.f, 0.f};
    if (fq < n4) v = *(const f32x4*)(part + (size_t)row * pitch + 4 * fq);
    float s = (v[0] + v[1]) + (v[2] + v[3]);
    s += __shfl_xor(s, 16); s += __shfl_xor(s, 32);
    return s;
}
namespace pg8 {
constexpr int BM = 256, BK = 64, HALF = 128, HTB = HALF * BK * 2, STAGE_BYTES = 8 * HTB, NXCD = 8, WGM = 8;
__device__ __forceinline__ int lds_byte(int r, int c) { const int st = (r >> 4) * 2 + (c >> 5), rr = r & 15, cc = c & 31, ob = rr * 64 + cc * 2; return st * 1024 + (ob ^ (((ob >> 9) & 1) << 5)); }
__device__ __forceinline__ void stage_rc(int b, int& R, int& C) { const int st = b / 1024, sb = b % 1024, swz = sb ^ (((sb >> 9) & 1) << 5); R = (st >> 1) * 16 + swz / 64; C = (st & 1) * 32 + (swz % 64) / 2; }
__device__ __forceinline__ int perm32(int rho) { const int n = rho >> 4, i = rho & 15; return 8 * (i >> 2) + 4 * n + (i & 3); }

struct Unit { int pm, pn; };
struct Gemm { const bf16_t* A; const bf16_t* Bt; int M, N, K, lda; };

struct StaticOrder {
    int nM, nN, nwg, G, c;
    __device__ __forceinline__ void init(int M, int N, int G_, int c_) { nM = M / BM; nN = N / BM; nwg = nM * nN; G = G_; c = c_; }
    __device__ __forceinline__ bool next(int i, Unit& u) const {
        const long L = (long)i * G + c; if (L >= nwg) return false;
        int wgid = (int)L; { const int q = nwg / NXCD, r = nwg % NXCD, xcd = wgid % NXCD, off = wgid / NXCD; wgid = (xcd < r ? xcd * (q + 1) : r * (q + 1) + (xcd - r) * q) + off; }
        const int nig = WGM * nN, gid = wgid / nig, fm = gid * WGM, gsz = (nM - fm) < WGM ? (nM - fm) : WGM;
        u.pm = fm + ((wgid % nig) % gsz); u.pn = (wgid % nig) / gsz; return true;
    }
};

template <class Epi>
__device__ __forceinline__ void gemm_phase(LAS unsigned char* lds, int wave_s, const Gemm g, const StaticOrder S, const Epi E) {
    const int tid = fresh_tid(wave_s);
    const int wid = __builtin_amdgcn_readfirstlane(tid >> 6), lane = tid & 63, wr = wid >> 2, wc = wid & 3, fr = lane & 15, fq = lane >> 4;
    const int K = g.K, nt = K / BK, lda = g.lda;
    unsigned voffA[2], voffB[2];
#pragma unroll
    for (int i = 0; i < 2; ++i) { int R, C; stage_rc(tid * 16 + i * 8192, R, C); const int Rb = Epi::PERM ? ((R & ~31) + perm32(R & 31)) : R;
        voffA[i] = (unsigned)(R * lda + C) * 2u; voffB[i] = (unsigned)(Rb * K + C) * 2u; }
    const size_t kstep = (size_t)(BK * 2);
    const size_t hstepA = (size_t)HALF * lda * 2, hstepB = (size_t)HALF * K * 2;
    const size_t tstepA = 2 * hstepA, tstepB = 2 * hstepB;
    const unsigned ldsw = (unsigned)wid * 1024u;
    const int aoff = lds_byte(wr * 64 + fr, fq * 8), boff = lds_byte(wc * 32 + fr, fq * 8);
#define PG8_SA(b, h) (((b) * 2 + (h)) * HTB)
#define PG8_SB(b, h) ((4 + (b) * 2 + (h)) * HTB)
#define PG8_STAGE(bufoff, gbase, voff) do { _Pragma("unroll") for (int _i = 0; _i < 2; ++_i) \
        __builtin_amdgcn_global_load_lds((const unsigned*)((const char*)(gbase) + (voff)[_i]), (LAS unsigned*)(lds + (bufoff) + ldsw + _i * 8192), 16, 0, 0); } while (0)
#define PG8_LDA(dst, b, h) do { _Pragma("unroll") for (int m = 0; m < 4; ++m) _Pragma("unroll") for (int k = 0; k < 2; ++k) dst[m][k] = *(const LAS bf16x8*)(lds + PG8_SA(b, h) + aoff + m * 2048 + k * 1024); } while (0)
#define PG8_LDB(dst, b, h) do { _Pragma("unroll") for (int n = 0; n < 2; ++n) _Pragma("unroll") for (int k = 0; k < 2; ++k) dst[n][k] = *(const LAS bf16x8*)(lds + PG8_SB(b, h) + boff + n * 2048 + k * 1024); } while (0)
#define PG8_MMA(ai, bj, At, Bt) do { __builtin_amdgcn_s_setprio(1); _Pragma("unroll") for (int m = 0; m < 4; ++m) _Pragma("unroll") for (int n = 0; n < 2; ++n) _Pragma("unroll") for (int k = 0; k < 2; ++k) \
        acc[ai][bj][m][n] = __builtin_amdgcn_mfma_f32_16x16x32_bf16(Bt[n][k], At[m][k], acc[ai][bj][m][n], 0, 0, 0); __builtin_amdgcn_s_setprio(0); } while (0)
#define PG8_WAIT_V(n) asm volatile("s_waitcnt vmcnt(" #n ")" ::: "memory")
#define PG8_WAIT_L(n) asm volatile("s_waitcnt lgkmcnt(" #n ")" ::: "memory")
#define PG8_BAR __builtin_amdgcn_s_barrier()
#define PG8_SCHED __builtin_amdgcn_sched_barrier(0)
    Unit cur, nxt; int ui = 0;
    if (!S.next(0, cur)) return;
    f32x4 acc[2][2][4][2];
#pragma unroll
    for (int a = 0; a < 2; ++a)
#pragma unroll
        for (int b = 0; b < 2; ++b)
#pragma unroll
            for (int m = 0; m < 4; ++m)
#pragma unroll
                for (int n = 0; n < 2; ++n) acc[a][b][m][n] = (f32x4){0.f, 0.f, 0.f, 0.f};
    bf16x8 At[4][2], B0[2][2], B1[2][2];
    const char* cA = (const char*)g.A + (size_t)cur.pm * tstepA; const char* cB = (const char*)g.Bt + (size_t)cur.pn * tstepB;
    PG8_STAGE(PG8_SB(0, 0), cB, voffB); PG8_STAGE(PG8_SB(0, 1), cB + hstepB, voffB); PG8_STAGE(PG8_SA(0, 0), cA, voffA); PG8_STAGE(PG8_SA(0, 1), cA + hstepA, voffA);
    if (wr == 1) PG8_BAR;
    PG8_WAIT_V(2); PG8_BAR;
    PG8_STAGE(PG8_SB(1, 0), cB + kstep, voffB); PG8_STAGE(PG8_SA(1, 0), cA + kstep, voffA); PG8_STAGE(PG8_SB(1, 1), cB + hstepB + kstep, voffB);
    PG8_WAIT_V(6); PG8_BAR;
    for (;;) {
        const bool has_next = S.next(ui + 1, nxt);
        const char* nA = has_next ? (const char*)g.A + (size_t)nxt.pm * tstepA : cA; const char* nB = has_next ? (const char*)g.Bt + (size_t)nxt.pn * tstepB : cB;
        for (int t = 0; t < nt; t += 2) {
            const bool last = (t == nt - 2);
            const char* a1 = cA + (size_t)(t + 1) * kstep;
            const char* a2 = last ? nA : cA + (size_t)(t + 2) * kstep; const char* b2 = last ? nB : cB + (size_t)(t + 2) * kstep;
            const char* a3 = a2 + kstep; const char* b3 = b2 + kstep;
            PG8_LDB(B0, 0, 0); PG8_LDB(B1, 0, 1); PG8_SCHED; PG8_LDA(At, 0, 0); PG8_STAGE(PG8_SA(1, 1), a1 + hstepA, voffA);
            PG8_WAIT_V(8); PG8_WAIT_L(0); PG8_BAR; PG8_MMA(0, 0, At, B0); PG8_MMA(0, 1, At, B1); PG8_BAR; PG8_SCHED;
            PG8_LDA(At, 0, 1); PG8_STAGE(PG8_SB(0, 0), b2, voffB); PG8_STAGE(PG8_SB(0, 1), b2 + hstepB, voffB); PG8_STAGE(PG8_SA(0, 0), a2, voffA);
            PG8_WAIT_V(8); PG8_WAIT_L(0); PG8_BAR; PG8_MMA(1, 0, At, B0); PG8_MMA(1, 1, At, B1); PG8_BAR; PG8_SCHED;
            PG8_LDB(B0, 1, 0); PG8_LDB(B1, 1, 1); PG8_SCHED; PG8_LDA(At, 1, 0); PG8_STAGE(PG8_SA(0, 1), a2 + hstepA, voffA);
            PG8_WAIT_V(8); PG8_WAIT_L(0); PG8_BAR; PG8_MMA(0, 0, At, B0); PG8_MMA(0, 1, At, B1); PG8_BAR; PG8_SCHED;
            PG8_LDA(At, 1, 1); PG8_STAGE(PG8_SB(1, 0), b3, voffB); PG8_STAGE(PG8_SB(1, 1), b3 + hstepB, voffB); PG8_STAGE(PG8_SA(1, 0), a3, voffA);
            PG8_WAIT_V(8); PG8_WAIT_L(0); PG8_BAR; PG8_MMA(1, 0, At, B0); PG8_MMA(1, 1, At, B1); PG8_BAR; PG8_SCHED;
        }
        if (wr == 0) PG8_BAR;
        E(acc, cur, wr, wc, fr, fq);
        if (!has_next) break;
#pragma unroll
        for (int a = 0; a < 2; ++a)
#pragma unroll
            for (int b = 0; b < 2; ++b)
#pragma unroll
                for (int m = 0; m < 4; ++m)
#pragma unroll
                    for (int n = 0; n < 2; ++n) acc[a][b][m][n] = (f32x4){0.f, 0.f, 0.f, 0.f};
        cur = nxt; cA = nA; cB = nB; ++ui;
        if (wr == 1) PG8_BAR;
    }
    PG8_WAIT_V(0);
    PG8_BAR;
#undef PG8_SA
#undef PG8_SB
#undef PG8_STAGE
#undef PG8_LDA
#undef PG8_LDB
#undef PG8_MMA
#undef PG8_WAIT_V
#undef PG8_WAIT_L
#undef PG8_BAR
#undef PG8_SCHED
}

struct EpiSwiglu {
    static constexpr bool PERM = true;
    bf16_t* O; const float* ssq;
    __device__ __forceinline__ void operator()(const f32x4 (&acc)[2][2][4][2], const Unit& u, int wr, int wc, int fr, int fq) const {
        const int row0 = u.pm * BM + wr * 64 + fr, col0 = u.pn * 128 + wc * 32 + 8 * fq;
#pragma unroll
        for (int ai = 0; ai < 2; ++ai)
#pragma unroll
            for (int m = 0; m < 4; ++m) {
                const int row = row0 + ai * HALF + m * 16;
                const float rs = rsqrtf(row_ssq(ssq, 16, 4, row, fq) * (1.f / 1024.f) + EPS);
                float r[8];
#pragma unroll
                for (int n = 0; n < 2; ++n)
#pragma unroll
                    for (int e = 0; e < 4; ++e) { const float gv = acc[ai][0][m][n][e] * rs, uv = acc[ai][1][m][n][e] * rs; r[n * 4 + e] = gv * fast_sigmoid(gv) * uv; }
                u32x4 w; w.x = pk2(r[0], r[1]); w.y = pk2(r[2], r[3]); w.z = pk2(r[4], r[5]); w.w = pk2(r[6], r[7]);
                *(u32x4*)(O + (size_t)row * DFF + col0) = w;
            }
    }
};
template <bool GATED>
struct EpiResid {
    static constexpr bool PERM = true;
    const bf16_t* HI; bf16_t* HO; bf16_t* LO; float* ssq_out; const float* ssq_in; const bf16_t* PP; float alpha; float pad_;
    __device__ __forceinline__ void operator()(const f32x4 (&acc)[2][2][4][2], const Unit& u, int wr, int wc, int fr, int fq) const {
        const int row0 = u.pm * BM + wr * 64 + fr, col0 = u.pn * BM + wc * 32 + 8 * fq;
#pragma unroll
        for (int ai = 0; ai < 2; ++ai)
#pragma unroll
            for (int m = 0; m < 4; ++m) {
                const int row = row0 + ai * HALF + m * 16;
                float rs = 0.f; if (GATED) rs = rsqrtf(row_ssq(ssq_in, 16, 4, row, fq) * (1.f / 1024.f) + EPS);
                float sq = 0.f;
#pragma unroll
                for (int bj = 0; bj < 2; ++bj) {
                    const size_t off = (size_t)row * DM + col0 + bj * HALF;
                    const u32x4 hh = *(const u32x4*)(HI + off), ll = *(const u32x4*)(LO + off);
                    float hv[8] = {bflo(hh.x) + bflo(ll.x), bfhi(hh.x) + bfhi(ll.x), bflo(hh.y) + bflo(ll.y), bfhi(hh.y) + bfhi(ll.y),
                                   bflo(hh.z) + bflo(ll.z), bfhi(hh.z) + bfhi(ll.z), bflo(hh.w) + bflo(ll.w), bfhi(hh.w) + bfhi(ll.w)};
                    float av[8] = {acc[ai][bj][m][0][0], acc[ai][bj][m][0][1], acc[ai][bj][m][0][2], acc[ai][bj][m][0][3], acc[ai][bj][m][1][0], acc[ai][bj][m][1][1], acc[ai][bj][m][1][2], acc[ai][bj][m][1][3]};
                    if (GATED) { const u32x4 pp = *(const u32x4*)(PP + off);
                        const float pv[8] = {bflo(pp.x), bfhi(pp.x), bflo(pp.y), bfhi(pp.y), bflo(pp.z), bfhi(pp.z), bflo(pp.w), bfhi(pp.w)};
#pragma unroll
                        for (int e = 0; e < 8; ++e) av[e] = fast_sigmoid(av[e] * rs) * pv[e]; }
                    else {
#pragma unroll
                        for (int e = 0; e < 8; ++e) av[e] *= alpha; }
                    float lo[8];
#pragma unroll
                    for (int e = 0; e < 8; ++e) { hv[e] += av[e]; sq += hv[e] * hv[e]; }
                    u32x4 wh; wh.x = pk2(hv[0], hv[1]); wh.y = pk2(hv[2], hv[3]); wh.z = pk2(hv[4], hv[5]); wh.w = pk2(hv[6], hv[7]);
                    lo[0] = hv[0] - bflo(wh.x); lo[1] = hv[1] - bfhi(wh.x); lo[2] = hv[2] - bflo(wh.y); lo[3] = hv[3] - bfhi(wh.y);
                    lo[4] = hv[4] - bflo(wh.z); lo[5] = hv[5] - bfhi(wh.z); lo[6] = hv[6] - bflo(wh.w); lo[7] = hv[7] - bfhi(wh.w);
                    u32x4 wl; wl.x = pk2(lo[0], lo[1]); wl.y = pk2(lo[2], lo[3]); wl.z = pk2(lo[4], lo[5]); wl.w = pk2(lo[6], lo[7]);
                    *(u32x4*)(HO + off) = wh; *(u32x4*)(LO + off) = wl;
                }
                sq += __shfl_xor(sq, 16); sq += __shfl_xor(sq, 32);
                if (fq == 0) ssq_out[(size_t)row * 16 + 4 * u.pn + wc] = sq;
            }
    }
};
struct EpiGen {
    static constexpr bool PERM = true;
    bf16_t* O; int ldc; const float* ssq_in; float inv_k; int mode; float* ssq_q; float* ssq_kv; const float* rope; int in_pitch; int in_n4;
    __device__ __forceinline__ void operator()(const f32x4 (&acc)[2][2][4][2], const Unit& u, int wr, int wc, int fr, int fq) const {
        const int row0 = u.pm * BM + wr * 64 + fr;
        float rsv[2][4];
#pragma unroll
        for (int ai = 0; ai < 2; ++ai)
#pragma unroll
            for (int m = 0; m < 4; ++m) rsv[ai][m] = ssq_in ? rsqrtf(row_ssq(ssq_in, in_pitch, in_n4, row0 + ai * HALF + m * 16, fq) * inv_k + EPS) : 1.f;
#pragma unroll
        for (int bj = 0; bj < 2; ++bj) {
            const int c0 = u.pn * BM + bj * HALF + wc * 32;
            float scale = 1.f; bool sig = false, rp = false, st = true; float* sq = nullptr; int sqp = 0;
            if (mode == 1) { const int slab = c0 >> 7;
                if (slab < 3) { sq = ssq_q + 4 * slab + wc; sqp = 16; } else if (slab < 5) { sq = ssq_kv + 4 * (slab - 3) + wc; sqp = 8; } else if (slab == 5) { rp = (wc == 0); st = (wc == 0); }
                else if (slab < 14) scale = C2_64; else if (slab < 18) {} else if (slab < 26) scale = C2_64; else if (slab < 42) {} else sig = true;
            } else if (mode == 2) { rp = ((c0 % 96) == 64); scale = C2_96; }
            if (!st) continue;
#pragma unroll
            for (int ai = 0; ai < 2; ++ai)
#pragma unroll
                for (int m = 0; m < 4; ++m) {
                    const int row = row0 + ai * HALF + m * 16; const float rs = rsv[ai][m] * scale;
                    f32x4 v0 = acc[ai][bj][m][0] * rs, v1 = acc[ai][bj][m][1] * rs;
                    if (rp) {
                        const int pos = row & (SEQ - 1); const float* rb = rope + pos * 32 + 8 * (fq & 1); const bool hi2 = (fq >> 1) != 0;
                        const f32x4 cs0 = *(const f32x4*)(rb), cs1 = *(const f32x4*)(rb + 4), sn0 = *(const f32x4*)(rb + 16), sn1 = *(const f32x4*)(rb + 20);
#pragma unroll
                        for (int e = 0; e < 4; ++e) { const float q0 = __shfl_xor(v0[e], 32), q1 = __shfl_xor(v1[e], 32);
                            v0[e] = hi2 ? v0[e] * cs0[e] + q0 * sn0[e] : v0[e] * cs0[e] - q0 * sn0[e];
                            v1[e] = hi2 ? v1[e] * cs1[e] + q1 * sn1[e] : v1[e] * cs1[e] - q1 * sn1[e]; } }
                    if (sig) {
#pragma unroll
                        for (int e = 0; e < 4; ++e) { v0[e] = fast_sigmoid(v0[e]); v1[e] = fast_sigmoid(v1[e]); } }
                    if (sq) { float s = (v0[0] * v0[0] + v0[1] * v0[1]) + (v0[2] * v0[2] + v0[3] * v0[3]) + (v1[0] * v1[0] + v1[1] * v1[1]) + (v1[2] * v1[2] + v1[3] * v1[3]);
                        s += __shfl_xor(s, 16); s += __shfl_xor(s, 32); if (fq == 0) sq[(size_t)row * sqp] = s; }
                    u32x4 w; w.x = pk2(v0[0], v0[1]); w.y = pk2(v0[2], v0[3]); w.z = pk2(v1[0], v1[1]); w.w = pk2(v1[2], v1[3]);
                    *(u32x4*)(O + (size_t)row * ldc + c0 + 8 * fq) = w;
                }
        }
    }
};
}

constexpr int ATT_LUT_OFF = 61440;
template <int DQK, int DV, int MODE, bool RES = false>
__device__ __forceinline__ void flash_core(LAS unsigned char* lds, int wave_s, const bf16_t* Qp, int qpitch, const bf16_t* K1, int k1pitch, const bf16_t* K2, int k2pitch,
                                           const bf16_t* Vp, int vpitch, int q0, int kt_lo, int kt_hi, const LAS float* lut, float sink2, f32x16 (&o)[DV / 32], int win_lo = 0) {
    constexpr int CH = DQK / 8, KS = DQK * 2 + 16, KBUF = 64 * KS, VBUF = 64 * DV * 2, VCH = DV / 8;
    constexpr int NKI = (64 * CH + 511) / 512, NVI = (64 * VCH) / 512, NDB = DV / 32;
    static_assert(RES || 2 * KBUF + 2 * VBUF <= ATT_LUT_OFF, "attention LDS");
    LAS unsigned char* Kl = lds; LAS unsigned char* Vl = lds + (RES ? 8 : 2) * KBUF;
    const int tid = fresh_tid(wave_s);
    const int lane = tid & 63, wid = __builtin_amdgcn_readfirstlane(tid >> 6), r32 = lane & 31, h = lane >> 5;
    bf16x8 qf[DQK / 16];
    { const bf16_t* qrow = Qp + (size_t)(32 * wid + r32) * qpitch + 8 * h;
#pragma unroll
      for (int d0 = 0; d0 < DQK / 16; ++d0) qf[d0] = *(const bf16x8*)(qrow + 16 * d0); }
    float mrun = -INFINITY, lrun = 0.f;
#pragma unroll
    for (int db = 0; db < NDB; ++db)
#pragma unroll
        for (int r = 0; r < 16; ++r) o[db][r] = 0.f;
    const int qw0 = q0 + 32 * wid, qpos = qw0 + r32;
    const bf16x8 ones = (bf16x8){(short)0x3F80, (short)0x3F80, (short)0x3F80, (short)0x3F80, (short)0x3F80, (short)0x3F80, (short)0x3F80, (short)0x3F80};
    u32x4 kreg[NKI], vreg[NVI];
    const unsigned char* ksrc[NKI]; unsigned kstep[NKI]; int kdst[NKI]; bool kval[NKI];
#pragma unroll
    for (int i_ = 0; i_ < NKI; ++i_) { const int idx = tid + 512 * i_; const int key = idx / CH, c = idx % CH; kval[i_] = (idx < 64 * CH);
        if (c < 8) { ksrc[i_] = (const unsigned char*)(K1 + (size_t)key * k1pitch + 8 * c); kstep[i_] = (unsigned)(128 * k1pitch); }
        else       { ksrc[i_] = (const unsigned char*)(K2 + (size_t)key * k2pitch + 8 * (c - 8)); kstep[i_] = (unsigned)(128 * k2pitch); }
        if (!kval[i_]) { ksrc[i_] = (const unsigned char*)K1; kstep[i_] = 0u; }
        kdst[i_] = key * KS + 16 * c; }
    const unsigned char* vsrc0; int vdst0;
    { const int key = tid / VCH, c = tid % VCH; vsrc0 = (const unsigned char*)(Vp + (size_t)key * vpitch + 8 * c); vdst0 = (c >> 2) * 4096 + (key >> 3) * 512 + (key & 7) * 64 + (c & 3) * 16; }
    const unsigned vrowoff = (unsigned)((512 / VCH) * vpitch * 2);
    constexpr int VDSTOFF = ((512 / VCH) >> 3) * 512;
    const unsigned vstep = (unsigned)(128 * vpitch);
#define FA_LOADK(kt) do { _Pragma("unroll") for (int i_ = 0; i_ < NKI; ++i_) kreg[i_] = *(const u32x4*)(ksrc[i_] + (size_t)(unsigned)(kt) * kstep[i_]); } while (0)
#define FA_LOADV(kt) do { _Pragma("unroll") for (int i_ = 0; i_ < NVI; ++i_) vreg[i_] = *(const u32x4*)(vsrc0 + (size_t)(unsigned)(kt) * vstep + (size_t)i_ * vrowoff); } while (0)
#define FA_STOREK(buf) do { _Pragma("unroll") for (int i_ = 0; i_ < NKI; ++i_) { if (kval[i_]) *(LAS u32x4*)(Kl + (buf) * KBUF + kdst[i_]) = kreg[i_]; } } while (0)
#define FA_STOREV(buf) do { _Pragma("unroll") for (int i_ = 0; i_ < NVI; ++i_) *(LAS u32x4*)(Vl + (buf) * VBUF + vdst0 + i_ * VDSTOFF) = vreg[i_]; } while (0)
#define FA_QK(P0, P1, kbuf, CI) do { const LAS unsigned char* kb_ = Kl + (kbuf) * KBUF + r32 * KS + 16 * h; \
    _Pragma("unroll") for (int d0 = 0; d0 < DQK / 16; ++d0) { \
        const bf16x8 a0 = *(const LAS bf16x8*)(kb_ + 32 * d0), a1 = *(const LAS bf16x8*)(kb_ + 32 * KS + 32 * d0); \
        if (d0 == 0) { P0 = __builtin_amdgcn_mfma_f32_32x32x16_bf16(a0, qf[0], CI, 0, 0, 0); P1 = __builtin_amdgcn_mfma_f32_32x32x16_bf16(a1, qf[0], CI, 0, 0, 0); } \
        else { P0 = __builtin_amdgcn_mfma_f32_32x32x16_bf16(a0, qf[d0], P0, 0, 0, 0); P1 = __builtin_amdgcn_mfma_f32_32x32x16_bf16(a1, qf[d0], P1, 0, 0, 0); } } } while (0)
#define SBAR() __builtin_amdgcn_sched_barrier(0)
#define FA_CHUNK(c, p0, p1) do { \
    if ((c) < 4) { ma = max3f(ma, p0[4 * (c)], p0[4 * (c) + 1]); mb = max3f(mb, p0[4 * (c) + 2], p0[4 * (c) + 3]); ma = max3f(ma, p1[4 * (c)], p1[4 * (c) + 1]); mb = max3f(mb, p1[4 * (c) + 2], p1[4 * (c) + 3]); } \
    else if ((c) == 4) { float rm = max2f(ma, mb); { auto rr_ = __builtin_amdgcn_permlane32_swap(__float_as_uint(rm), __float_as_uint(rm), false, false); rm = max2f(__uint_as_float(rr_[0]), __uint_as_float(rr_[1])); } \
        if (NEGM) {   \
            const bool need_ = __any(rm > 5.0f || rm < -40.0f); pendf = need_; pend = 0.f; alpha = 1.f; \
            if (need_) { const float dl_ = (rm > 0.f || rm < -40.0f) ? rm : 0.f; _Pragma("unroll") for (int r_ = 0; r_ < 16; ++r_) { p0[r_] -= dl_; p1[r_] -= dl_; } \
                alpha = __builtin_amdgcn_exp2f(-dl_); mrun += dl_; pend = dl_; } } \
        else { rm += ctile;   \
        const bool need_ = __any(rm > mrun + 5.0f); const float mnew = need_ ? max2f(mrun, rm) : mrun; const float muse = (mnew == -INFINITY) ? 0.f : mnew; alpha = __builtin_amdgcn_exp2f(mrun - muse); mrun = mnew; msub = muse - ctile; } } \
    else if ((c) < 9) { _Pragma("unroll") for (int e_ = 0; e_ < 4; ++e_) p0[4 * ((c) - 5) + e_] = NEGM ? __builtin_amdgcn_exp2f(p0[4 * ((c) - 5) + e_]) : __builtin_amdgcn_exp2f(p0[4 * ((c) - 5) + e_] - msub); \
        asm volatile("" : "+v"(p0[4 * ((c) - 5)]), "+v"(p0[4 * ((c) - 5) + 1]), "+v"(p0[4 * ((c) - 5) + 2]), "+v"(p0[4 * ((c) - 5) + 3])); } \
    else { _Pragma("unroll") for (int e_ = 0; e_ < 4; ++e_) p1[4 * ((c) - 9) + e_] = NEGM ? __builtin_amdgcn_exp2f(p1[4 * ((c) - 9) + e_]) : __builtin_amdgcn_exp2f(p1[4 * ((c) - 9) + e_] - msub); \
        asm volatile("" : "+v"(p1[4 * ((c) - 9)]), "+v"(p1[4 * ((c) - 9) + 1]), "+v"(p1[4 * ((c) - 9) + 2]), "+v"(p1[4 * ((c) - 9) + 3])); } } while (0)
#define FA_GAP(g, p0, p1) do { if ((g) + 1 <= 8) FA_CHUNK((g) + 1, p0, p1); SBAR(); } while (0)
#define FA_KFRAG(d) (*(const LAS bf16x8*)(kb_ + 32 * (d))), (*(const LAS bf16x8*)(kb_ + 32 * KS + 32 * (d)))
#define FA_STEP(p0, p1, SN0, SN1, t) do { const int tt_ = (t) - kt_lo; float ctile = 0.f; \
    if (MODE == 2) { const int tlo = 64 * (t); \
        if (tlo + 63 - qw0 <= -128) { if (!NEGM) ctile = lut[0]; } else if (tlo - (qw0 + 31) >= 128) { if (!NEGM) ctile = lut[511]; } \
        else { const LAS float* lq_ = lut + (tlo + 4 * h - qpos + 256); _Pragma("unroll") for (int r = 0; r < 16; ++r) { p0[r] += lq_[(r & 3) + 8 * (r >> 2)]; p1[r] += lq_[(r & 3) + 8 * (r >> 2) + 32]; } } } \
    if (MODE == 1) { const LAS float* lp_ = lut + (64 * (t) + 4 * h - qpos + 320); \
        _Pragma("unroll") for (int r = 0; r < 16; ++r) { p0[r] += lp_[(r & 3) + 8 * (r >> 2)]; p1[r] += lp_[(r & 3) + 8 * (r >> 2) + 32]; } } \
    if (NEGM) { if (pendf) { _Pragma("unroll") for (int r_ = 0; r_ < 16; ++r_) { p0[r_] -= pend; p1[r_] -= pend; } } \
        float cn_ = 0.f; if (MODE == 2) { const int tl1 = 64 * ((t) + 1); if (tl1 + 63 - qw0 <= -128) cn_ = lut[0]; else if (tl1 - (qw0 + 31) >= 128) cn_ = lut[511]; } \
        const float cb_ = cn_ - mrun; if (__any(cb_ != cbs)) { cbs = cb_; _Pragma("unroll") for (int r_ = 0; r_ < 16; ++r_) negc[r_] = cb_; } } \
    SBAR(); \
      \
    float ma = -INFINITY, mb = -INFINITY, alpha = 1.f, msub = 0.f; \
    bf16x8 vfr[4][NDB]; const LAS unsigned char* vbs_ = Vl + (RES ? ((t) - win_lo) : (tt_ & 1)) * VBUF + vlane; \
    { const LAS unsigned char* kb_ = Kl + (RES ? (min((t) + 1, kt_hi - 1) - win_lo) : ((tt_ + 1) & 1)) * KBUF + r32 * KS + 16 * h; \
      bf16x8 kf[DQK / 16][2]; \
      kf[0][0] = *(const LAS bf16x8*)(kb_); kf[0][1] = *(const LAS bf16x8*)(kb_ + 32 * KS); kf[1][0] = *(const LAS bf16x8*)(kb_ + 32); kf[1][1] = *(const LAS bf16x8*)(kb_ + 32 * KS + 32); \
      if (KD > 2) { kf[2][0] = *(const LAS bf16x8*)(kb_ + 64); kf[2][1] = *(const LAS bf16x8*)(kb_ + 32 * KS + 64); } \
      if (!RES) { FA_LOADK(min((t) + 2, kt_hi - 1)); FA_LOADV(min((t) + 1, kt_hi - 1)); } \
      FA_CHUNK(0, p0, p1); SBAR(); \
      _Pragma("unroll") for (int d0 = 0; d0 < DQK / 16; ++d0) { \
        if (d0 + KD < DQK / 16) { kf[d0 + KD][0] = *(const LAS bf16x8*)(kb_ + 32 * (d0 + KD)); kf[d0 + KD][1] = *(const LAS bf16x8*)(kb_ + 32 * KS + 32 * (d0 + KD)); } \
        if (VPRE && (d0 == 1 || d0 == 2)) { _Pragma("unroll") for (int db = 0; db < NDB; ++db) { const LAS unsigned char* vp = vbs_ + db * 4096 + (d0 - 1) * 1024; \
            const v4i16_t lo = __builtin_amdgcn_ds_read_tr16_b64_v4i16((LAS v4i16_t*)vp); const v4i16_t hi = __builtin_amdgcn_ds_read_tr16_b64_v4i16((LAS v4i16_t*)(vp + 512)); \
            vfr[d0 - 1][db] = (bf16x8){lo[0], lo[1], lo[2], lo[3], hi[0], hi[1], hi[2], hi[3]}; } } \
        if (d0 == 0) SN0 = __builtin_amdgcn_mfma_f32_32x32x16_bf16(kf[0][0], qf[0], NEGM ? negc : zero16, 0, 0, 0); else SN0 = __builtin_amdgcn_mfma_f32_32x32x16_bf16(kf[d0][0], qf[d0], SN0, 0, 0, 0); \
        FA_GAP(2 * d0, p0, p1); \
        if (d0 == 0) SN1 = __builtin_amdgcn_mfma_f32_32x32x16_bf16(kf[0][1], qf[0], NEGM ? negc : zero16, 0, 0, 0); else SN1 = __builtin_amdgcn_mfma_f32_32x32x16_bf16(kf[d0][1], qf[d0], SN1, 0, 0, 0); \
        FA_GAP(2 * d0 + 1, p0, p1); } } \
    if (!__all(alpha == 1.0f)) { _Pragma("unroll") for (int db = 0; db < NDB; ++db) _Pragma("unroll") for (int r = 0; r < 16; ++r) o[db][r] *= alpha; } \
    SBAR(); \
      \
    { f32x16 lacc; u32x4 pw, pwn; \
      pw.x = pk2(p0[0], p0[1]); pw.y = pk2(p0[2], p0[3]); pw.z = pk2(p0[4], p0[5]); pw.w = pk2(p0[6], p0[7]); pwn = pw; \
      if (!VPRE) { _Pragma("unroll") for (int s_ = 0; s_ < 2; ++s_) _Pragma("unroll") for (int db = 0; db < NDB; ++db) { const LAS unsigned char* vp = vbs_ + db * 4096 + s_ * 1024; \
            const v4i16_t lo = __builtin_amdgcn_ds_read_tr16_b64_v4i16((LAS v4i16_t*)vp); const v4i16_t hi = __builtin_amdgcn_ds_read_tr16_b64_v4i16((LAS v4i16_t*)(vp + 512)); \
            vfr[s_][db] = (bf16x8){lo[0], lo[1], lo[2], lo[3], hi[0], hi[1], hi[2], hi[3]}; } } \
      SBAR(); \
      _Pragma("unroll") for (int s4 = 0; s4 < 4; ++s4) { \
        const bf16x8 pb = __builtin_bit_cast(bf16x8, pw); \
        lacc = __builtin_amdgcn_mfma_f32_32x32x16_bf16(ones, pb, (s4 == 0) ? zero16 : lacc, 0, 0, 0); \
        if (s4 == 0) { pwn.x = pk2(p0[8], p0[9]); pwn.y = pk2(p0[10], p0[11]); pwn.z = pk2(p0[12], p0[13]); pwn.w = pk2(p0[14], p0[15]); } \
        if (s4 == 1) { pwn.x = pk2(p1[0], p1[1]); pwn.y = pk2(p1[2], p1[3]); pwn.z = pk2(p1[4], p1[5]); pwn.w = pk2(p1[6], p1[7]); } \
        if (s4 == 2) { pwn.x = pk2(p1[8], p1[9]); pwn.y = pk2(p1[10], p1[11]); pwn.z = pk2(p1[12], p1[13]); pwn.w = pk2(p1[14], p1[15]); } \
        SBAR(); \
        _Pragma("unroll") for (int db = 0; db < NDB; ++db) { \
            o[db] = __builtin_amdgcn_mfma_f32_32x32x16_bf16(vfr[s4][db], pb, o[db], 0, 0, 0); \
            if (s4 < 2) { const LAS unsigned char* vp = vbs_ + db * 4096 + (s4 + 2) * 1024; \
                const v4i16_t lo = __builtin_amdgcn_ds_read_tr16_b64_v4i16((LAS v4i16_t*)vp); const v4i16_t hi = __builtin_amdgcn_ds_read_tr16_b64_v4i16((LAS v4i16_t*)(vp + 512)); \
                vfr[s4 + 2][db] = (bf16x8){lo[0], lo[1], lo[2], lo[3], hi[0], hi[1], hi[2], hi[3]}; } \
            if (s4 < 2 && db >= NDB - 2) FA_CHUNK(9 + 2 * s4 + (db - (NDB - 2)), p0, p1); \
            SBAR(); } \
        pw = pwn; } \
      lrun = lrun * alpha + lacc[0]; } \
    if (!RES) { FA_STOREK(tt_ & 1); FA_STOREV((tt_ + 1) & 1); __syncthreads(); } } while (0)
    const int vlane = (4 * h + ((lane & 15) >> 2)) * 64 + ((lane >> 4) & 1) * 32 + (lane & 3) * 8;
    f32x16 zero16;
#pragma unroll
    for (int r = 0; r < 16; ++r) zero16[r] = 0.f;
    f32x16 pA0 = zero16, pA1 = zero16, pB0 = zero16, pB1 = zero16;
    constexpr bool VPRE = (DV <= 64); constexpr int KD = (DV <= 64) ? 3 : 2;
    constexpr bool NEGM = (MODE != 1);
    f32x16 negc = zero16; float cbs = 0.f, pend = 0.f; bool pendf = false;
    if (NEGM) mrun = 0.f;
    if (!RES) {
        u32x4 k2_[NKI];
        FA_LOADK(kt_lo); FA_LOADV(kt_lo);
#pragma unroll
        for (int i_ = 0; i_ < NKI; ++i_) k2_[i_] = *(const u32x4*)(ksrc[i_] + (size_t)(unsigned)(kt_lo + 1) * kstep[i_]);
        FA_STOREK(0); FA_STOREV(0);
#pragma unroll
        for (int i_ = 0; i_ < NKI; ++i_) { if (kval[i_]) *(LAS u32x4*)(Kl + KBUF + kdst[i_]) = k2_[i_]; }
        __syncthreads();
        if (NEGM) { if (MODE == 2) {     const int tl0 = 64 * kt_lo; float c0_ = 0.f; if (tl0 + 63 - qw0 <= -128) c0_ = lut[0]; else if (tl0 - (qw0 + 31) >= 128) c0_ = lut[511]; cbs = c0_;
#pragma unroll
        for (int r_ = 0; r_ < 16; ++r_) negc[r_] = c0_; } }
        FA_QK(pA0, pA1, 0, negc);
        __syncthreads();
    } else {
        FA_QK(pA0, pA1, kt_lo - win_lo, zero16);
    }
    for (int kt = kt_lo; kt < kt_hi; kt += 2) {
        FA_STEP(pA0, pA1, pB0, pB1, kt);
        FA_STEP(pB0, pB1, pA0, pA1, kt + 1);
    }
#undef SBAR
#undef FA_CHUNK
#undef FA_KFRAG
#undef FA_GAP
#undef FA_LOADK
#undef FA_LOADV
#undef FA_STOREK
#undef FA_STOREV
#undef FA_QK
#undef FA_STEP
    float lt = lrun;
    if (MODE == 1) lt += __builtin_amdgcn_exp2f(sink2 - mrun);
    const float inv = 1.f / lt;
#pragma unroll
    for (int db = 0; db < NDB; ++db)
#pragma unroll
        for (int r = 0; r < 16; ++r) o[db][r] *= inv;
}

template <int DV, bool ACCUM>
__device__ __forceinline__ void attn_store(const f32x16 (&o)[DV / 32], const bf16_t* gate_row, bf16_t* merged_row, int h) {
#pragma unroll
    for (int db = 0; db < DV / 32; ++db)
#pragma unroll
        for (int rg = 0; rg < 4; ++rg) {
            const int d = 32 * db + 8 * rg + 4 * h;
            const u32x2 g = *(const u32x2*)(gate_row + d);
            float v0 = o[db][4 * rg + 0] * bflo(g.x), v1 = o[db][4 * rg + 1] * bfhi(g.x), v2 = o[db][4 * rg + 2] * bflo(g.y), v3 = o[db][4 * rg + 3] * bfhi(g.y);
            if (ACCUM) { const u32x2 mm = *(const u32x2*)(merged_row + d); v0 += bflo(mm.x); v1 += bfhi(mm.x); v2 += bflo(mm.y); v3 += bfhi(mm.y); }
            u32x2 w; w.x = pk2(v0, v1); w.y = pk2(v2, v3);
            *(u32x2*)(merged_row + d) = w;
            if (rg == 3) __builtin_amdgcn_sched_barrier(0);
        }
}

__device__ __forceinline__ void build_lut(LAS float* lut, const float* rel_table, int col, int wave_s) {
    const int tid = fresh_tid(wave_s);
    if (tid < 257) {
        const int rel = tid - 128, n = rel < 0 ? -rel : rel, base = rel > 0 ? 16 : 0; int bkt;
        if (n < 8) bkt = n; else { const unsigned t = (unsigned)(n * n) >> 6; const int k = 31 - __clz((int)t); bkt = min(8 + k, 15); }
        lut[tid] = rel_table[(base + bkt) * 24 + col] * LOG2E;
    }
}

__device__ __forceinline__ void build_lut_dense(LAS float* lut, const float* rel_table, int col, int wave_s) {
    const int tid = fresh_tid(wave_s);
    { const int rel = tid - 256, n = rel < 0 ? -rel : rel, base = rel > 0 ? 16 : 0; int bkt;
      if (n < 8) bkt = n; else { const unsigned t = (unsigned)(n * n) >> 6; const int k = 31 - __clz((int)t); bkt = min(8 + k, 15); }
      lut[tid] = rel_table[(base + bkt) * 24 + col] * LOG2E; }
}

__device__ __forceinline__ void build_lut_pad(LAS float* lut, const float* rel_table, int col, int wave_s) {
    const int tid = fresh_tid(wave_s);
    for (int i = tid; i < 640; i += 512) {
        const int rel = i - 320, n = rel < 0 ? -rel : rel, base = rel > 0 ? 16 : 0; int bkt;
        if (n < 8) bkt = n; else { const unsigned t = (unsigned)(n * n) >> 6; const int k = 31 - __clz((int)t); bkt = min(8 + k, 15); }
        lut[i] = (n <= 128) ? rel_table[(base + bkt) * 24 + col] * LOG2E : -INFINITY;
    }
}

typedef unsigned gu32_t;
#define RLX_AGENT __ATOMIC_RELAXED, __HIP_MEMORY_SCOPE_AGENT
#define XB_TMO      128
#define XB_XCNT(j)  (256  + 64 * (j))
#define XB_XSUB(j)  (1280 + 64 * (j))
#define XB_XGEN(j)  (2304 + 64 * (j))
#define XB_TOP      3328
#define XB_TOPGEN   3392
#define XCD_BAR_WORDS 3456
#define XB_SPIN_CAP (1u << 18)

__device__ __forceinline__ unsigned xb_ld(unsigned* p)              { return __hip_atomic_load(p, __ATOMIC_RELAXED, __HIP_MEMORY_SCOPE_AGENT); }
__device__ __forceinline__ unsigned xb_add(unsigned* p, unsigned v) { return __hip_atomic_fetch_add(p, v, __ATOMIC_RELAXED, __HIP_MEMORY_SCOPE_AGENT); }
__device__ __forceinline__ unsigned xb_xcc_id() { return (unsigned)__builtin_amdgcn_s_getreg((3 << 11) | 20) & 0xFu; }
#define XB_SPIN(cond, bar) do { unsigned _sp = 0; while (cond) { __builtin_amdgcn_s_sleep(1); \
    if ((++_sp & 255u) == 0u) { if (xb_ld(&(bar)[XB_TMO])) break; if (_sp > XB_SPIN_CAP) { atomicAdd(&(bar)[XB_TMO], 1u); break; } } } } while (0)

struct XcdBarrier {
    unsigned* bar; unsigned x;
    volatile LAS unsigned* st;
};

__device__ __forceinline__ XcdBarrier xcd_barrier_post(unsigned* bar, volatile LAS unsigned* st) {
    XcdBarrier b; b.bar = bar; b.x = xb_xcc_id(); b.st = st;
    if (threadIdx.x == 0) (void)xb_add(&bar[XB_XCNT(b.x)], 1u);
    return b;
}
__device__ __forceinline__ void xcd_barrier_complete(unsigned* bar, unsigned x, unsigned& nloc, unsigned& nx) {
    const unsigned G = gridDim.x * gridDim.y * gridDim.z;
    unsigned sum, cnt, mine, sp = 0u;
    for (;;) {
        sum = 0u; cnt = 0u; mine = 0u;
#pragma unroll
        for (unsigned j = 0; j < 16; ++j) { const unsigned c = xb_ld(&bar[XB_XCNT(j)]); sum += c; cnt += (c > 0u) ? 1u : 0u; mine = (j == x) ? c : mine; }
        if (sum == G) break;
        __builtin_amdgcn_s_sleep(1);
        if ((++sp & 255u) == 0u) { if (xb_ld(&bar[XB_TMO])) break; if (sp > XB_SPIN_CAP) { atomicAdd(&bar[XB_TMO], 1u); break; } }
    }
    nloc = mine > 0u ? mine : 1u; nx = cnt > 0u ? cnt : 1u;
}

__device__ __forceinline__ void xcd_barrier(const XcdBarrier& b) {
    asm volatile("s_waitcnt vmcnt(0)" ::: "memory");
    __syncthreads();
    if (threadIdx.x == 0) {
        unsigned* bar = b.bar;
        __builtin_amdgcn_s_waitcnt(0);
        unsigned nloc = b.st[0], nx = b.st[1];
        if (nloc == 0u) { xcd_barrier_complete(bar, b.x, nloc, nx); b.st[0] = nloc; b.st[1] = nx; }
        const unsigned old = xb_add(&bar[XB_XSUB(b.x)], 1u);
        const unsigned gen = old / nloc;
        if (old + 1u == (gen + 1u) * nloc) {
            __builtin_amdgcn_fence(__ATOMIC_RELEASE, "agent");
            asm volatile("s_waitcnt vmcnt(0)" ::: "memory");
            const unsigned og = xb_add(&bar[XB_TOP], 1u);
            const unsigned tg = og / nx;
            if (og + 1u == (tg + 1u) * nx) xb_add(&bar[XB_TOPGEN], 1u);
            else XB_SPIN(xb_ld(&bar[XB_TOPGEN]) == tg, bar);
            __builtin_amdgcn_fence(__ATOMIC_ACQUIRE, "agent");
            xb_add(&bar[XB_XGEN(b.x)], 1u);
            asm volatile("s_waitcnt vmcnt(0)" ::: "memory");
        } else {
            XB_SPIN(xb_ld(&bar[XB_XGEN(b.x)]) == gen, bar);
            __builtin_amdgcn_fence(__ATOMIC_ACQUIRE, "agent");
            asm volatile("s_waitcnt vmcnt(0)" ::: "memory");
        }
    }
    __syncthreads();
}


struct Args { const float* in[28]; float* out; unsigned char* ws; };

__device__ __forceinline__ void conv_item(const float* W, int K, int N, const float* gain, bf16_t* WT, int dst_row0, LAS float* scr, int kb, int n0, int lane) {
    const int k0 = 64 * kb;
    float v[32];
    const float* wp = W + (size_t)(k0 + (lane >> 5)) * N + n0 + (lane & 31);
#pragma unroll
    for (int i = 0; i < 32; ++i) v[i] = wp[(size_t)(2 * i) * N];
    if (gain) {
#pragma unroll
        for (int i = 0; i < 32; ++i) v[i] *= gain[k0 + 2 * i + (lane >> 5)];
    }
#pragma unroll
    for (int i = 0; i < 32; ++i) scr[(2 * i + (lane >> 5)) * 33 + (lane & 31)] = v[i];
    asm volatile("s_waitcnt lgkmcnt(0)" ::: "memory");
    const int c = lane & 7;
#pragma unroll
    for (int j = 0; j < 4; ++j) { const int n = (lane >> 3) + 8 * j; const LAS float* s = scr + (8 * c) * 33 + n;
        u32x4 o; o.x = pk2(s[0 * 33], s[1 * 33]); o.y = pk2(s[2 * 33], s[3 * 33]); o.z = pk2(s[4 * 33], s[5 * 33]); o.w = pk2(s[6 * 33], s[7 * 33]);
        *(u32x4*)(WT + (size_t)(dst_row0 + n) * K + k0 + 8 * c) = o; }
    asm volatile("s_waitcnt lgkmcnt(0)" ::: "memory");
}

__global__ void __launch_bounds__(512) fwd_megakernel(Args a) {
    extern __shared__ __attribute__((aligned(16))) unsigned char lds_raw[];
    LAS unsigned char* lds = (LAS unsigned char*)lds_raw;
    cg::grid_group grid = cg::this_grid();
#define GSYNC() do { asm volatile("s_waitcnt vmcnt(0) lgkmcnt(0)" ::: "memory"); __syncthreads(); grid.sync(); } while (0)
    { volatile LAS unsigned* st0 = (volatile LAS unsigned*)(lds + 147456 - 64); if (threadIdx.x < 16) st0[threadIdx.x] = 0u; }
    __syncthreads();
    const XcdBarrier xbar = xcd_barrier_post((unsigned*)(a.ws + WS_BAR), (volatile LAS unsigned*)(lds + 147456 - 64));
#define XSYNC() do { asm volatile("s_waitcnt vmcnt(0) lgkmcnt(0)" ::: "memory"); xcd_barrier(xbar); } while (0)
    const int wave_s = __builtin_amdgcn_readfirstlane(threadIdx.x >> 6);
    const int G = gridDim.x, bx = blockIdx.x, vcu = (G % 8 == 0) ? (bx % 8) * (G / 8) + bx / 8 : bx;
    const int NGW = G * 8;
#define FRESH_IDS const int tid = fresh_tid(wave_s); const int lane = tid & 63, wave = wave_s, gw = vcu * 8 + wave; (void)lane; (void)gw; (void)tid;
    unsigned char* ws = a.ws;
    float* PH0 = (float*)(ws + WS_PH0); float* PH1 = (float*)(ws + WS_PH1); float* PH2 = (float*)(ws + WS_PH2); float* PH3 = (float*)(ws + WS_PH3);
    float* PQ = (float*)(ws + WS_PQ); float* PKV = (float*)(ws + WS_PKV);
    float* rope = (float*)(ws + WS_ROPE);
    bf16_t* Wb = (bf16_t*)(ws + WS_W);
    bf16_t* PB = (bf16_t*)(ws + WS_PB);
    bf16_t* HB = (bf16_t*)(ws + WS_HB);
    bf16_t* ACT = (bf16_t*)(ws + WS_ACT);
    bf16_t* QA = (bf16_t*)(ws + WS_QA);
    bf16_t* KVA = (bf16_t*)(ws + WS_KVA);
    bf16_t* HID = (bf16_t*)(ws + WS_HID);
    bf16_t* PPJ = (bf16_t*)(ws + WS_PPJ);
    float* Hf = a.out;
    bf16_t* LOP = (bf16_t*)((unsigned char*)a.out + (size_t)128 * MiB);
    const float* rel_table = a.in[18];

    {
        FRESH_IDS
        const float* x = a.in[0];
        for (int m = gw; m < MTOK; m += NGW) {
            const f32x4* xr = (const f32x4*)(x + (size_t)m * DM) + lane; u32x2* l8 = (u32x2*)(LOP + (size_t)m * DM) + lane;
            u32x2* o8 = (u32x2*)(HB + (size_t)m * DM) + lane; float s = 0.f;
#pragma unroll
            for (int j = 0; j < 4; ++j) { const f32x4 v = xr[64 * j]; s += (v[0] * v[0] + v[1] * v[1]) + (v[2] * v[2] + v[3] * v[3]); u32x2 w; w.x = pk2(v[0], v[1]); w.y = pk2(v[2], v[3]); o8[64 * j] = w;
                u32x2 wl; wl.x = pk2(v[0] - bflo(w.x), v[1] - bfhi(w.x)); wl.y = pk2(v[2] - bflo(w.y), v[3] - bfhi(w.y)); l8[64 * j] = wl; }
            s = wave_sum(s); if (lane < 16) PH0[(size_t)m * 16 + lane] = (lane == 0) ? s : 0.f;
        }
        const int gt = gw * 64 + lane, NGT = NGW * 64;
        { u32x4* z = (u32x4*)(Wb + W_IN + (size_t)672 * DM); for (int i = gt; i < 96 * DM / 8; i += NGT) z[i] = (u32x4){0u, 0u, 0u, 0u}; }
        for (int i = gt; i < SEQ * 16; i += NGT) { const int pos = i >> 4, k = i & 15; const float inv = exp2f(-(float)k * 0.8304820237218406f); const float ang = (float)pos * inv;
            float r = ang * 0.15915494309189535f; r = r - floorf(r); rope[pos * 32 + k] = __builtin_amdgcn_cosf(r); rope[pos * 32 + 16 + k] = __builtin_amdgcn_sinf(r); }
    }

#pragma nounroll
    for (int L = 0; L < DEPTH; ++L) {
        {
            FRESH_IDS
            LAS float* scr = (LAS float*)(lds + wave * 16384);
            const float* g_ffn1 = a.in[2] + (size_t)L * DM; const float* g_mix = a.in[6] + (size_t)L * DM; const float* g_q = a.in[8] + (size_t)L * 384; const float* g_kv = a.in[10] + (size_t)L * 256;
            const float* g_ffn2 = a.in[20] + (size_t)L * DM; const float* g_ple = a.in[24] + (size_t)L * DM;
            const float* w_g1 = a.in[3] + (size_t)L * DM * DFF; const float* w_u1 = a.in[4] + (size_t)L * DM * DFF; const float* w_d1 = a.in[5] + (size_t)L * DFF * DM;
            const float* w_in = a.in[7] + (size_t)L * DM * INW; const float* w_uq = a.in[9] + (size_t)L * 384 * QAW; const float* w_ukv = a.in[11] + (size_t)L * 256 * KVAW;
            const float* w_out = a.in[19] + (size_t)L * DM * DM;
            const float* w_g2 = a.in[21] + (size_t)L * DM * DFF; const float* w_u2 = a.in[22] + (size_t)L * DM * DFF; const float* w_d2 = a.in[23] + (size_t)L * DFF * DM;
            const float* w_pg = a.in[25] + (size_t)L * DM * DM; const float* w_pp = a.in[26] + (size_t)L * PLE * DM;
            constexpr int I_G = 16 * 88, I_D = 44 * 32, I_IN = 16 * 261, I_UQ = 6 * 48, I_UKV = 4 * 64, I_SQ = 16 * 32, I_PP = 4 * 32;
            constexpr int NITEMS = 4 * I_G + 2 * I_D + I_IN + I_UQ + I_UKV + 2 * I_SQ + I_PP;
#define CONV_MAT(CNT, W_, K_, N_, G_, DST_, MAPEXPR) if (r < (CNT)) { const int nblk = (N_) / 32, kb = r / nblk, n0 = (r % nblk) * 32; conv_item(W_, K_, N_, G_, DST_, (MAPEXPR), scr, kb, n0, lane); continue; } r -= (CNT);
            for (int it = gw; it < NITEMS; it += NGW) {
                int r = it;
                CONV_MAT(I_G, w_g1, DM, DFF, g_ffn1, Wb + W_GU1, (n0 >> 7) * 256 + (n0 & 127))
                CONV_MAT(I_G, w_u1, DM, DFF, g_ffn1, Wb + W_GU1, (n0 >> 7) * 256 + 128 + (n0 & 127))
                CONV_MAT(I_D, w_d1, DFF, DM, (const float*)nullptr, Wb + W_D1, n0)
                CONV_MAT(I_IN, w_in, DM, INW, g_mix, Wb + W_IN, (n0 < 672 ? n0 : n0 + 96))
                CONV_MAT(I_UQ, w_uq, 384, QAW, g_q, Wb + W_UQ, n0)
                CONV_MAT(I_UKV, w_ukv, 256, KVAW, g_kv, Wb + W_UKV, n0)
                CONV_MAT(I_SQ, w_out, DM, DM, (const float*)nullptr, Wb + W_OUT, n0)
                CONV_MAT(I_G, w_g2, DM, DFF, g_ffn2, Wb + W_GU2, (n0 >> 7) * 256 + (n0 & 127))
                CONV_MAT(I_G, w_u2, DM, DFF, g_ffn2, Wb + W_GU2, (n0 >> 7) * 256 + 128 + (n0 & 127))
                CONV_MAT(I_D, w_d2, DFF, DM, (const float*)nullptr, Wb + W_D2, n0)
                CONV_MAT(I_SQ, w_pg, DM, DM, g_ple, Wb + W_PG, n0)
                CONV_MAT(I_PP, w_pp, PLE, DM, (const float*)nullptr, Wb + W_PP, n0)
            }
#undef CONV_MAT
            const int gt = gw * 64 + lane, NGT = NGW * 64;
            { const f32x4* ps = (const f32x4*)(a.in[1] + (size_t)L * MTOK * PLE); u32x4* pd = (u32x4*)PB;
              for (int i = gt; i < MTOK * PLE / 8; i += NGT) { const f32x4 v0 = ps[2 * i], v1 = ps[2 * i + 1]; u32x4 w; w.x = pk2(v0[0], v0[1]); w.y = pk2(v0[2], v0[3]); w.z = pk2(v1[0], v1[1]); w.w = pk2(v1[2], v1[3]); pd[i] = w; } }
        }
        GSYNC();

        float* ssq0 = PH0; float* ssq1 = PH1; float* ssq2 = PH2; float* ssq3 = PH3; float* ssq4 = PH0;

        { pg8::Gemm g{(L == 0) ? HB : (const bf16_t*)QA, Wb + W_GU1, MTOK, 2 * DFF, DM, DM}; pg8::StaticOrder S; S.init(MTOK, 2 * DFF, G, bx);
          pg8::EpiSwiglu E{HID, ssq0}; pg8::gemm_phase(lds, wave_s, g, S, E); }
        XSYNC();
        { pg8::Gemm g{HID, Wb + W_D1, MTOK, DM, DFF, DFF}; pg8::StaticOrder S; S.init(MTOK, DM, G, bx);
          pg8::EpiResid<false> E{(L == 0) ? HB : (const bf16_t*)QA, HB, LOP, ssq1, nullptr, nullptr, 0.5f, 0.f}; pg8::gemm_phase(lds, wave_s, g, S, E); }
        XSYNC();

#pragma nounroll
        for (int ck = 0; ck < NCHUNK; ++ck) {
            const size_t r0 = (size_t)ck * MC;
            { pg8::Gemm g{HB + r0 * DM, Wb + W_IN, MC, INP, DM, DM}; pg8::StaticOrder S; S.init(MC, INP, G, bx);
              pg8::EpiGen E{ACT, INP, ssq1 + r0 * 16, 1.f / 1024.f, 1, PQ, PKV, rope, 16, 4}; pg8::gemm_phase(lds, wave_s, g, S, E); }
            XSYNC();
            { pg8::Gemm g{ACT + C_CQ, Wb + W_UQ, MC, QAW, 384, INP}; pg8::StaticOrder S; S.init(MC, QAW, G, bx);
              pg8::EpiGen E{QA, QAW, PQ, 1.f / 384.f, 2, nullptr, nullptr, rope, 16, 3}; pg8::gemm_phase(lds, wave_s, g, S, E); }
            { pg8::Gemm g{ACT + C_CKV, Wb + W_UKV, MC, KVAW, 256, INP}; pg8::StaticOrder S; S.init(MC, KVAW, G, bx);
              pg8::EpiGen E{KVA, KVAW, PKV, 1.f / 256.f, 0, nullptr, nullptr, rope, 8, 2}; pg8::gemm_phase(lds, wave_s, g, S, E); }
            XSYNC();
            {
            FRESH_IDS
            for (int u = vcu; u < NB_CHUNK * 16 * 8; u += G) {
                const int qb = u & 7, hh = (u >> 3) & 15, b = u >> 7; const size_t tok0 = (size_t)b * SEQ;
                f32x16 o[2];
                flash_core<96, 64, 0>(lds, wave_s, QA + (tok0 + 256 * qb) * QAW + 96 * hh, QAW, KVA + tok0 * KVAW + 128 * hh, KVAW, ACT + tok0 * INP + C_KR, INP,
                                      KVA + tok0 * KVAW + 128 * hh + 64, KVAW, 256 * qb, 0, SEQ / 64, (const LAS float*)(lds + ATT_LUT_OFF), 0.f, o);
                const int l2 = fresh_tid(wave_s) & 63;
                bf16_t* row = ACT + (tok0 + 256 * qb + 32 * wave + (l2 & 31)) * INP + C_GA + 64 * hh;
                attn_store<64, false>(o, row, row, l2 >> 5);
            }
            }
            XSYNC();
            {
            FRESH_IDS
            constexpr int SW_KBUF = 64 * 144, SW_VBUF = 8192, SW_LUT = 8 * SW_KBUF + 8 * SW_VBUF;
            for (int u = vcu; u < NB_CHUNK * 4 * 8; u += G) {
                const int qb = u & 7, kvh = (u >> 3) & 3, b = u >> 5; const size_t tok0 = (size_t)b * SEQ;
                const int q0 = 256 * qb; const int klo = max(0, (q0 - 128) >> 6), khi = min(SEQ / 64, (q0 + 384) >> 6);
                __syncthreads();
                { const int t2 = fresh_tid(wave_s); const int key = t2 >> 3, c = t2 & 7;
                  const bf16_t* kp = ACT + (tok0 + 64 * klo + key) * INP + C_KB + 64 * kvh + 8 * c; const bf16_t* vp = ACT + (tok0 + 64 * klo + key) * INP + C_VB + 64 * kvh + 8 * c;
                  LAS unsigned char* kd = lds + key * 144 + 16 * c; LAS unsigned char* vd = lds + 8 * SW_KBUF + (c >> 2) * 4096 + (key >> 3) * 512 + (key & 7) * 64 + (c & 3) * 16;
                  for (int i = 0; i < khi - klo; i += 2) {
                      const u32x4 k0 = *(const u32x4*)(kp + (size_t)(64 * i) * INP), v0 = *(const u32x4*)(vp + (size_t)(64 * i) * INP);
                      const u32x4 k1 = *(const u32x4*)(kp + (size_t)(64 * (i + 1)) * INP), v1 = *(const u32x4*)(vp + (size_t)(64 * (i + 1)) * INP);
                      *(LAS u32x4*)(kd + i * SW_KBUF) = k0; *(LAS u32x4*)(vd + i * SW_VBUF) = v0; *(LAS u32x4*)(kd + (i + 1) * SW_KBUF) = k1; *(LAS u32x4*)(vd + (i + 1) * SW_VBUF) = v1; } }
                const int qw0 = q0 + 32 * wave; int wlo = max(klo, (qw0 - 128) >> 6), whi = min(khi, ((qw0 + 159) >> 6) + 1);
                if ((whi - wlo) & 1) { if (whi < khi) ++whi; else --wlo; }
#pragma nounroll
                for (int g = 0; g < 4; ++g) {
                    const int hh = 4 * kvh + g;
                    __syncthreads();
                    build_lut_pad((LAS float*)(lds + SW_LUT), rel_table, hh, wave_s);
                    __syncthreads();
                    const float sink2 = a.in[12][L * 16 + hh] * LOG2E;
                    f32x16 o[2];
                    flash_core<64, 64, 1, true>(lds, wave_s, ACT + (tok0 + q0) * INP + C_QB + 64 * hh, INP, nullptr, 0, nullptr, 0, nullptr, 0, q0, wlo, whi,
                                                (const LAS float*)(lds + SW_LUT), sink2, o, klo);
                    const int l2 = fresh_tid(wave_s) & 63;
                    bf16_t* row = ACT + (tok0 + q0 + 32 * wave + (l2 & 31)) * INP;
                    attn_store<64, true>(o, row + C_GB + 64 * hh, row + C_GA + 64 * hh, l2 >> 5);
                }
            }
            }
            XSYNC();
            {
                FRESH_IDS
                int Lv = L; asm volatile("" : "+s"(Lv));
                const unsigned lib = (Lv == 0) ? __float_as_uint(0.2f) : (Lv == 1) ? __float_as_uint(0.35550906759096926f) : (Lv == 2) ? __float_as_uint(0.47071301834358416f) : __float_as_uint(0.5560582041556405f);
                const unsigned omb = (Lv == 0) ? __float_as_uint(0.8f) : (Lv == 1) ? __float_as_uint(0.64449093240903074f) : (Lv == 2) ? __float_as_uint(0.52928698165641584f) : __float_as_uint(0.4439417958443595f);
                const float lambda_init = __uint_as_float(lib);
                float s1 = 0.f, s2 = 0.f;
                for (int k_ = 0; k_ < 64; ++k_) { s1 += a.in[13][Lv * 64 + k_] * a.in[14][Lv * 64 + k_]; s2 += a.in[15][Lv * 64 + k_] * a.in[16][Lv * 64 + k_]; }
                const float lam = uniformf(expf(s1) - expf(s2) + lambda_init);
                const float* subln = a.in[17] + Lv * 128;
                float* scr_blk = (float*)(ws + WS_SCR) + (size_t)bx * (64 * 512);
                for (int u = vcu; u < NB_CHUNK * 8 * 8; u += G) {
                    const int qb = u & 7, hh = (u >> 3) & 7, b = u >> 6; const size_t tok0 = (size_t)b * SEQ; const int q0 = 256 * qb;
                    LAS float* lut = (LAS float*)(lds + ATT_LUT_OFF);
                    build_lut_dense(lut, rel_table, 16 + hh, wave_s);
                    { int Lw = Lv; asm volatile("" : "+s"(Lw));
                      const unsigned ob_ = (Lw == 0) ? __float_as_uint(0.8f) : (Lw == 1) ? __float_as_uint(0.64449093240903074f) : (Lw == 2) ? __float_as_uint(0.52928698165641584f) : __float_as_uint(0.4439417958443595f);
                      if (lane_id() == 0) ((LAS unsigned*)lut)[520] = ob_; }
                    f32x16 o[4];
                    flash_core<64, 128, 2>(lds, wave_s, ACT + (tok0 + q0) * INP + C_QC + 128 * hh, INP, ACT + tok0 * INP + C_KC + 128 * hh, INP, nullptr, 0,
                                           ACT + tok0 * INP + C_VC + 128 * hh, INP, q0, 0, SEQ / 64, lut, 0.f, o);
                    { f32x4* scr = (f32x4*)(scr_blk + (size_t)fresh_tid(wave_s) * 64);
#pragma unroll
                    for (int db = 0; db < 4; ++db)
#pragma unroll
                        for (int j = 0; j < 4; ++j) scr[db * 4 + j] = (f32x4){o[db][4 * j], o[db][4 * j + 1], o[db][4 * j + 2], o[db][4 * j + 3]}; }
                    flash_core<64, 128, 2>(lds, wave_s, ACT + (tok0 + q0) * INP + C_QC + 128 * hh + 64, INP, ACT + tok0 * INP + C_KC + 128 * hh + 64, INP, nullptr, 0,
                                           ACT + tok0 * INP + C_VC + 128 * hh, INP, q0, 0, SEQ / 64, lut, 0.f, o);
                    float ss = 0.f;
                    const int t3 = fresh_tid(wave_s), l3 = t3 & 63;
                    const f32x4* scr = (const f32x4*)(scr_blk + (size_t)t3 * 64);
#pragma unroll
                    for (int db = 0; db < 4; ++db)
                    {
#pragma unroll
                      for (int j = 0; j < 4; ++j) { const f32x4 t4 = scr[db * 4 + j];
#pragma unroll
                            for (int e = 0; e < 4; ++e) { const float v = t4[e] - lam * o[db][4 * j + e]; o[db][4 * j + e] = v; ss += v * v; } }
                      __builtin_amdgcn_sched_barrier(0); }
                    ss += __shfl_xor(ss, 32);
                    const float rs = rsqrtf(ss * (1.f / 128.f) + EPS) * lut[520];
                    const int hl = l3 >> 5;
#pragma unroll
                    for (int db = 0; db < 4; ++db)
                    {
#pragma unroll
                      for (int rg = 0; rg < 4; ++rg) { const f32x4 gn = *(const f32x4*)(subln + 32 * db + 8 * rg + 4 * hl);
#pragma unroll
                            for (int e = 0; e < 4; ++e) o[db][4 * rg + e] *= rs * gn[e]; }
                      __builtin_amdgcn_sched_barrier(0); }
                    bf16_t* row = ACT + (tok0 + q0 + 32 * wave + (l3 & 31)) * INP;
                    attn_store<128, true>(o, row + C_GC + 128 * hh, row + C_GA + 128 * hh, hl);
                }
            }
            XSYNC();
            { pg8::Gemm g{ACT + C_GA, Wb + W_OUT, MC, DM, DM, INP}; pg8::StaticOrder S; S.init(MC, DM, G, bx);
              pg8::EpiResid<false> E{HB + r0 * DM, HB + r0 * DM, LOP + r0 * DM, ssq2 + r0 * 16, nullptr, nullptr, 1.0f, 0.f}; pg8::gemm_phase(lds, wave_s, g, S, E); }
            XSYNC();
        }
        { pg8::Gemm g{HB, Wb + W_GU2, MTOK, 2 * DFF, DM, DM}; pg8::StaticOrder S; S.init(MTOK, 2 * DFF, G, bx);
          pg8::EpiSwiglu E{HID, ssq2}; pg8::gemm_phase(lds, wave_s, g, S, E); }
        { pg8::Gemm g{PB, Wb + W_PP, MTOK, DM, PLE, PLE}; pg8::StaticOrder S; S.init(MTOK, DM, G, bx);
          pg8::EpiGen E{PPJ, DM, nullptr, 0.f, 0, nullptr, nullptr, rope, 16, 0}; pg8::gemm_phase(lds, wave_s, g, S, E); }
        XSYNC();
        { pg8::Gemm g{HID, Wb + W_D2, MTOK, DM, DFF, DFF}; pg8::StaticOrder S; S.init(MTOK, DM, G, bx);
          pg8::EpiResid<false> E{HB, HB, LOP, ssq3, nullptr, nullptr, 0.5f, 0.f}; pg8::gemm_phase(lds, wave_s, g, S, E); }
        XSYNC();
        { pg8::Gemm g{HB, Wb + W_PG, MTOK, DM, DM, DM}; pg8::StaticOrder S; S.init(MTOK, DM, G, bx);
          pg8::EpiResid<true> E{HB, QA, LOP, ssq4, ssq3, PPJ, 1.0f, 0.f}; pg8::gemm_phase(lds, wave_s, g, S, E); }
        XSYNC();
    }
    {
        FRESH_IDS
        const float* fg = a.in[27]; const float* ssqf = PH0;
        bf16_t* LOC = ACT;
#pragma nounroll
        for (int stage = 0; stage < 2; ++stage) {
            const int mbeg = stage * (MTOK / 2);
            const bf16_t* lsrc = stage ? (LOC - (size_t)(MTOK / 2) * DM) : LOP;
            for (int m = mbeg + gw; m < mbeg + MTOK / 2; m += NGW) {
                f32x4* hr = (f32x4*)(Hf + (size_t)m * DM) + lane; const u32x2* hb = (const u32x2*)(QA + (size_t)m * DM) + lane; const u32x2* lb = (const u32x2*)(lsrc + (size_t)m * DM) + lane;
                const f32x4* pp_ = (const f32x4*)(ssqf + (size_t)m * 16); const f32x4 q0_ = pp_[0], q1_ = pp_[1], q2_ = pp_[2], q3_ = pp_[3];
                const float tot_ = (((q0_[0] + q0_[1]) + (q0_[2] + q0_[3])) + ((q1_[0] + q1_[1]) + (q1_[2] + q1_[3]))) + (((q2_[0] + q2_[1]) + (q2_[2] + q2_[3])) + ((q3_[0] + q3_[1]) + (q3_[2] + q3_[3])));
                const float rs = rsqrtf(tot_ * (1.f / 1024.f) + EPS);
#pragma unroll
                for (int j = 0; j < 4; ++j) { const f32x4 gn = *((const f32x4*)fg + lane + 64 * j); const u32x2 wh = hb[64 * j], wl = lb[64 * j];
                    f32x4 v = (f32x4){bflo(wh.x) + bflo(wl.x), bfhi(wh.x) + bfhi(wl.x), bflo(wh.y) + bflo(wl.y), bfhi(wh.y) + bfhi(wl.y)}; v = v * rs * gn; hr[64 * j] = v; }
            }
            if (stage == 0) {
                const u32x4* src = (const u32x4*)(LOP + (size_t)(MTOK / 2) * DM); u32x4* dst = (u32x4*)LOC;
                const int gt = gw * 64 + lane, NGT = NGW * 64;
                for (int i = gt; i < (MTOK / 2) * DM / 8; i += NGT) dst[i] = src[i];
                XSYNC();
            }
        }
    }
}

constexpr int LDS_BYTES = 147456;

extern "C" void kernel_launch(void* const* d_in, const int* in_sizes, int n_in, void* d_out, int out_size, void* d_ws, size_t ws_size, hipStream_t stream) {
    static int grid = 0;
    if (grid == 0) {
        if (n_in != 28 || out_size != MTOK * DM || ws_size < WS_END) { fprintf(stderr, "kernel_launch: unexpected shapes (n_in %d out %d ws %zu)\n", n_in, out_size, ws_size); grid = -1; return; }
        int dev = 0, cus = 0, per_cu = 0;
        hipGetDevice(&dev);
        hipDeviceGetAttribute(&cus, hipDeviceAttributeMultiprocessorCount, dev);
        hipFuncSetAttribute((const void*)fwd_megakernel, hipFuncAttributeMaxDynamicSharedMemorySize, LDS_BYTES);
        hipOccupancyMaxActiveBlocksPerMultiprocessor(&per_cu, (const void*)fwd_megakernel, 512, LDS_BYTES);
        if (per_cu < 1) per_cu = 1;
        if (per_cu > 1) per_cu = 1;
        grid = cus * per_cu;
        if (grid > 256) grid = 256;
        (void)hipGetLastError();
    }
    if (grid < 0) return;
    Args a{};
    for (int i = 0; i < 28; ++i) a.in[i] = (const float*)d_in[i];
    a.out = (float*)d_out; a.ws = (unsigned char*)d_ws;
    (void)hipMemsetAsync((char*)d_ws + WS_BAR, 0, 16384, stream);
    void* kargs[] = {&a};
    hipError_t e = hipLaunchCooperativeKernel((const void*)fwd_megakernel, dim3(grid), dim3(512), kargs, LDS_BYTES, stream);
    if (e != hipSuccess) fprintf(stderr, "cooperative launch failed: %s (grid %d)\n", hipGetErrorString(e), grid);
}
```

```cpp
#include <hip/hip_runtime.h>
#include <hip/hip_cooperative_groups.h>
#include <cstdio>
#include <cstdint>
#include <cmath>
namespace cg = cooperative_groups;

#define LAS __attribute__((address_space(3)))
typedef unsigned short bf16_t;
typedef short bf16x8 __attribute__((ext_vector_type(8)));
typedef float f32x4 __attribute__((ext_vector_type(4)));
typedef float f32x16 __attribute__((ext_vector_type(16)));
typedef unsigned u32x4 __attribute__((ext_vector_type(4)));
typedef unsigned u32x2 __attribute__((ext_vector_type(2)));
typedef short v4i16_t __attribute__((ext_vector_type(4)));
typedef float f32x2_t __attribute__((ext_vector_type(2)));
typedef __bf16 bf16x2_t __attribute__((ext_vector_type(2)));

constexpr int DM = 1024, SEQ = 2048, DEPTH = 4, MTOK = 65536, DFF = 2816, PLE = 256;
constexpr int NB_CHUNK = 16, MC = NB_CHUNK * SEQ, NCHUNK = 2;
constexpr int INW = 8352, INP = 8448;
constexpr int C_CQ = 0, C_CKV = 384, C_KR = 640, C_QB = 768, C_KB = 1792, C_VB = 2048, C_QC = 2304, C_KC = 3328, C_VC = 4352, C_GA = 5376, C_GB = 6400, C_GC = 7424;
constexpr int QAW = 1536, KVAW = 2048;
constexpr float EPS = 1e-6f;
constexpr float LOG2E = 1.4426950408889634f;
constexpr float C2_64 = 0.125f * 1.4426950408889634f;
constexpr float C2_96 = 0.10206207261596577f * 1.4426950408889634f;

constexpr size_t MiB = 1u << 20;
constexpr size_t WS_PH0 = 0, WS_PQ = 4 * MiB, WS_PKV = 6 * MiB;
constexpr size_t WS_PH1 = 1012 * MiB, WS_PH2 = 1016 * MiB, WS_PH3 = 1020 * MiB;
constexpr size_t WS_ROPE = 7 * MiB;
constexpr size_t WS_BAR = 7 * MiB + 512 * 1024;
constexpr size_t WS_W = 8 * MiB;
constexpr size_t WS_PB = 66 * MiB;
constexpr size_t WS_HB = 98 * MiB;
constexpr size_t WS_ACT = 226 * MiB;
constexpr size_t WS_QA = 754 * MiB;
constexpr size_t WS_KVA = 850 * MiB;
constexpr size_t WS_HID = 226 * MiB;
constexpr size_t WS_PPJ = 578 * MiB;
constexpr size_t WS_SCR = 980 * MiB;
constexpr size_t WS_END = 1024 * MiB;
constexpr size_t W_GU1 = 0, W_D1 = W_GU1 + (size_t)2 * DFF * DM, W_IN = W_D1 + (size_t)DM * DFF, W_UQ = W_IN + (size_t)INP * DM,
                 W_UKV = W_UQ + (size_t)QAW * 384, W_OUT = W_UKV + (size_t)KVAW * 256, W_GU2 = W_OUT + (size_t)DM * DM,
                 W_D2 = W_GU2 + (size_t)2 * DFF * DM, W_PG = W_D2 + (size_t)DM * DFF, W_PP = W_PG + (size_t)DM * DM, W_ENDE = W_PP + (size_t)DM * PLE;
static_assert(W_ENDE * 2 <= 58 * MiB, "weights fit");

__device__ __forceinline__ unsigned pk2(float lo, float hi) { f32x2_t v = {lo, hi}; bf16x2_t b = __builtin_convertvector(v, bf16x2_t); return __builtin_bit_cast(unsigned, b); }
__device__ __forceinline__ float bflo(unsigned u) { return __uint_as_float(u << 16); }
__device__ __forceinline__ float bfhi(unsigned u) { return __uint_as_float(u & 0xffff0000u); }
__device__ __forceinline__ float wave_sum(float v) {
#pragma unroll
    for (int o = 1; o < 64; o <<= 1) v += __shfl_xor(v, o);
    return v;
}
__device__ __forceinline__ float max3f(float a, float b, float c) { float r; asm("v_max3_f32 %0, %1, %2, %3" : "=v"(r) : "v"(a), "v"(b), "v"(c)); return r; }
__device__ __forceinline__ float max2f(float a, float b) { float r; asm("v_max_f32_e32 %0, %1, %2" : "=v"(r) : "v"(a), "v"(b)); return r; }
__device__ __forceinline__ float fast_sigmoid(float x) { return __builtin_amdgcn_rcpf(1.f + __expf(-x)); }
__device__ __forceinline__ int lane_id() { int r; asm volatile("v_mbcnt_lo_u32_b32 %0, -1, 0\n\tv_mbcnt_hi_u32_b32 %0, -1, %0" : "=&v"(r)); return r; }
__device__ __forceinline__ int fresh_tid(int wave_s) { return wave_s * 64 + lane_id(); }
__device__ __forceinline__ float uniformf(float v) { return __uint_as_float(__builtin_amdgcn_readfirstlane(__float_as_uint(v))); }
__device__ __forceinline__ void atomic_addf(float* p, float v) { __hip_atomic_fetch_add(p, v, __ATOMIC_RELAXED, __HIP_MEMORY_SCOPE_AGENT); }

__device__ __forceinline__ float row_ssq(const float* part, int pitch, int n4, int row, int fq) {
    f32x4 v = (f32x4){0.f, 0.f, 0.f, 0.f};
    if (fq < n4) v = *(const f32x4*)(part + (size_t)row * pitch + 4 * fq);
    float s = (v[0] + v[1]) + (v[2] + v[3]);
    s += __shfl_xor(s, 16); s += __shfl_xor(s, 32);
    return s;
}
namespace pg8 {
constexpr int BM = 256, BK = 64, HALF = 128, HTB = HALF * BK * 2, STAGE_BYTES = 8 * HTB, NXCD = 8, WGM = 8;
__device__ __forceinline__ int lds_byte(int r, int c) { const int st = (r >> 4) * 2 + (c >> 5), rr = r & 15, cc = c & 31, ob = rr * 64 + cc * 2; return st * 1024 + (ob ^ (((ob >> 9) & 1) << 5)); }
__device__ __forceinline__ void stage_rc(int b, int& R, int& C) { const int st = b / 1024, sb = b % 1024, swz = sb ^ (((sb >> 9) & 1) << 5); R = (st >> 1) * 16 + swz / 64; C = (st & 1) * 32 + (swz % 64) / 2; }
__device__ __forceinline__ int perm32(int rho) { const int n = rho >> 4, i = rho & 15; return 8 * (i >> 2) + 4 * n + (i & 3); }

struct Unit { int pm, pn; };
struct Gemm { const bf16_t* A; const bf16_t* Bt; int M, N, K, lda; };

struct StaticOrder {
    int nM, nN, nwg, G, c;
    __device__ __forceinline__ void init(int M, int N, int G_, int c_) { nM = M / BM; nN = N / BM; nwg = nM * nN; G = G_; c = c_; }
    __device__ __forceinline__ bool next(int i, Unit& u) const {
        const long L = (long)i * G + c; if (L >= nwg) return false;
        int wgid = (int)L; { const int q = nwg / NXCD, r = nwg % NXCD, xcd = wgid % NXCD, off = wgid / NXCD; wgid = (xcd < r ? xcd * (q + 1) : r * (q + 1) + (xcd - r) * q) + off; }
        const int nig = WGM * nN, gid = wgid / nig, fm = gid * WGM, gsz = (nM - fm) < WGM ? (nM - fm) : WGM;
        u.pm = fm + ((wgid % nig) % gsz); u.pn = (wgid % nig) / gsz; return true;
    }
};

template <class Epi>
__device__ __forceinline__ void gemm_phase(LAS unsigned char* lds, int wave_s, const Gemm g, const StaticOrder S, const Epi E) {
    const int tid = fresh_tid(wave_s);
    const int wid = __builtin_amdgcn_readfirstlane(tid >> 6), lane = tid & 63, wr = wid >> 2, wc = wid & 3, fr = lane & 15, fq = lane >> 4;
    const int K = g.K, nt = K / BK, lda = g.lda;
    unsigned voffA[2], voffB[2];
#pragma unroll
    for (int i = 0; i < 2; ++i) { int R, C; stage_rc(tid * 16 + i * 8192, R, C); const int Rb = Epi::PERM ? ((R & ~31) + perm32(R & 31)) : R;
        voffA[i] = (unsigned)(R * lda + C) * 2u; voffB[i] = (unsigned)(Rb * K + C) * 2u; }
    const size_t kstep = (size_t)(BK * 2);
    const size_t hstepA = (size_t)HALF * lda * 2, hstepB = (size_t)HALF * K * 2;
    const size_t tstepA = 2 * hstepA, tstepB = 2 * hstepB;
    const unsigned ldsw = (unsigned)wid * 1024u;
    const int aoff = lds_byte(wr * 64 + fr, fq * 8), boff = lds_byte(wc * 32 + fr, fq * 8);
#define PG8_SA(b, h) (((b) * 2 + (h)) * HTB)
#define PG8_SB(b, h) ((4 + (b) * 2 + (h)) * HTB)
#define PG8_STAGE(bufoff, gbase, voff) do { _Pragma("unroll") for (int _i = 0; _i < 2; ++_i) \
        __builtin_amdgcn_global_load_lds((const unsigned*)((const char*)(gbase) + (voff)[_i]), (LAS unsigned*)(lds + (bufoff) + ldsw + _i * 8192), 16, 0, 0); } while (0)
#define PG8_LDA(dst, b, h) do { _Pragma("unroll") for (int m = 0; m < 4; ++m) _Pragma("unroll") for (int k = 0; k < 2; ++k) dst[m][k] = *(const LAS bf16x8*)(lds + PG8_SA(b, h) + aoff + m * 2048 + k * 1024); } while (0)
#define PG8_LDB(dst, b, h) do { _Pragma("unroll") for (int n = 0; n < 2; ++n) _Pragma("unroll") for (int k = 0; k < 2; ++k) dst[n][k] = *(const LAS bf16x8*)(lds + PG8_SB(b, h) + boff + n * 2048 + k * 1024); } while (0)
#define PG8_MMA(ai, bj, At, Bt) do { __builtin_amdgcn_s_setprio(1); _Pragma("unroll") for (int m = 0; m < 4; ++m) _Pragma("unroll") for (int n = 0; n < 2; ++n) _Pragma("unroll") for (int k = 0; k < 2; ++k) \
        acc[ai][bj][m][n] = __builtin_amdgcn_mfma_f32_16x16x32_bf16(Bt[n][k], At[m][k], acc[ai][bj][m][n], 0, 0, 0); __builtin_amdgcn_s_setprio(0); } while (0)
#define PG8_WAIT_V(n) asm volatile("s_waitcnt vmcnt(" #n ")" ::: "memory")
#define PG8_WAIT_L(n) asm volatile("s_waitcnt lgkmcnt(" #n ")" ::: "memory")
#define PG8_BAR __builtin_amdgcn_s_barrier()
#define PG8_SCHED __builtin_amdgcn_sched_barrier(0)
    Unit cur, nxt; int ui = 0;
    if (!S.next(0, cur)) return;
    f32x4 acc[2][2][4][2];
#pragma unroll
    for (int a = 0; a < 2; ++a)
#pragma unroll
        for (int b = 0; b < 2; ++b)
#pragma unroll
            for (int m = 0; m < 4; ++m)
#pragma unroll
                for (int n = 0; n < 2; ++n) acc[a][b][m][n] = (f32x4){0.f, 0.f, 0.f, 0.f};
    bf16x8 At[4][2], B0[2][2], B1[2][2];
    const char* cA = (const char*)g.A + (size_t)cur.pm * tstepA; const char* cB = (const char*)g.Bt + (size_t)cur.pn * tstepB;
    PG8_STAGE(PG8_SB(0, 0), cB, voffB); PG8_STAGE(PG8_SB(0, 1), cB + hstepB, voffB); PG8_STAGE(PG8_SA(0, 0), cA, voffA); PG8_STAGE(PG8_SA(0, 1), cA + hstepA, voffA);
    if (wr == 1) PG8_BAR;
    PG8_WAIT_V(2); PG8_BAR;
    PG8_STAGE(PG8_SB(1, 0), cB + kstep, voffB); PG8_STAGE(PG8_SA(1, 0), cA + kstep, voffA); PG8_STAGE(PG8_SB(1, 1), cB + hstepB + kstep, voffB);
    PG8_WAIT_V(6); PG8_BAR;
    for (;;) {
        const bool has_next = S.next(ui + 1, nxt);
        const char* nA = has_next ? (const char*)g.A + (size_t)nxt.pm * tstepA : cA; const char* nB = has_next ? (const char*)g.Bt + (size_t)nxt.pn * tstepB : cB;
        for (int t = 0; t < nt; t += 2) {
            const bool last = (t == nt - 2);
            const char* a1 = cA + (size_t)(t + 1) * kstep;
            const char* a2 = last ? nA : cA + (size_t)(t + 2) * kstep; const char* b2 = last ? nB : cB + (size_t)(t + 2) * kstep;
            const char* a3 = a2 + kstep; const char* b3 = b2 + kstep;
            PG8_LDB(B0, 0, 0); PG8_LDB(B1, 0, 1); PG8_SCHED; PG8_LDA(At, 0, 0); PG8_STAGE(PG8_SA(1, 1), a1 + hstepA, voffA);
            PG8_WAIT_V(8); PG8_WAIT_L(0); PG8_BAR; PG8_MMA(0, 0, At, B0); PG8_MMA(0, 1, At, B1); PG8_BAR; PG8_SCHED;
            PG8_LDA(At, 0, 1); PG8_STAGE(PG8_SB(0, 0), b2, voffB); PG8_STAGE(PG8_SB(0, 1), b2 + hstepB, voffB); PG8_STAGE(PG8_SA(0, 0), a2, voffA);
            PG8_WAIT_V(8); PG8_WAIT_L(0); PG8_BAR; PG8_MMA(1, 0, At, B0); PG8_MMA(1, 1, At, B1); PG8_BAR; PG8_SCHED;
            PG8_LDB(B0, 1, 0); PG8_LDB(B1, 1, 1); PG8_SCHED; PG8_LDA(At, 1, 0); PG8_STAGE(PG8_SA(0, 1), a2 + hstepA, voffA);
            PG8_WAIT_V(8); PG8_WAIT_L(0); PG8_BAR; PG8_MMA(0, 0, At, B0); PG8_MMA(0, 1, At, B1); PG8_BAR; PG8_SCHED;
            PG8_LDA(At, 1, 1); PG8_STAGE(PG8_SB(1, 0), b3, voffB); PG8_STAGE(PG8_SB(1, 1), b3 + hstepB, voffB); PG8_STAGE(PG8_SA(1, 0), a3, voffA);
            PG8_WAIT_V(8); PG8_WAIT_L(0); PG8_BAR; PG8_MMA(1, 0, At, B0); PG8_MMA(1, 1, At, B1); PG8_BAR; PG8_SCHED;
        }
        if (wr == 0) PG8_BAR;
        E(acc, cur, wr, wc, fr, fq);
        if (!has_next) break;
#pragma unroll
        for (int a = 0; a < 2; ++a)
#pragma unroll
            for (int b = 0; b < 2; ++b)
#pragma unroll
                for (int m = 0; m < 4; ++m)
#pragma unroll
                    for (int n = 0; n < 2; ++n) acc[a][b][m][n] = (f32x4){0.f, 0.f, 0.f, 0.f};
        cur = nxt; cA = nA; cB = nB; ++ui;
        if (wr == 1) PG8_BAR;
    }
    PG8_WAIT_V(0);
    PG8_BAR;
#undef PG8_SA
#undef PG8_SB
#undef PG8_STAGE
#undef PG8_LDA
#undef PG8_LDB
#undef PG8_MMA
#undef PG8_WAIT_V
#undef PG8_WAIT_L
#undef PG8_BAR
#undef PG8_SCHED
}

struct EpiSwiglu {
    static constexpr bool PERM = true;
    bf16_t* O; const float* ssq;
    __device__ __forceinline__ void operator()(const f32x4 (&acc)[2][2][4][2], const Unit& u, int wr, int wc, int fr, int fq) const {
        const int row0 = u.pm * BM + wr * 64 + fr, col0 = u.pn * 128 + wc * 32 + 8 * fq;
#pragma unroll
        for (int ai = 0; ai < 2; ++ai)
#pragma unroll
            for (int m = 0; m < 4; ++m) {
                const int row = row0 + ai * HALF + m * 16;
                const float rs = rsqrtf(row_ssq(ssq, 16, 4, row, fq) * (1.f / 1024.f) + EPS);
                float r[8];
#pragma unroll
                for (int n = 0; n < 2; ++n)
#pragma unroll
                    for (int e = 0; e < 4; ++e) { const float gv = acc[ai][0][m][n][e] * rs, uv = acc[ai][1][m][n][e] * rs; r[n * 4 + e] = gv * fast_sigmoid(gv) * uv; }
                u32x4 w; w.x = pk2(r[0], r[1]); w.y = pk2(r[2], r[3]); w.z = pk2(r[4], r[5]); w.w = pk2(r[6], r[7]);
                *(u32x4*)(O + (size_t)row * DFF + col0) = w;
            }
    }
};
template <bool GATED>
struct EpiResid {
    static constexpr bool PERM = true;
    const bf16_t* HI; bf16_t* HO; bf16_t* LO; float* ssq_out; const float* ssq_in; const bf16_t* PP; float alpha; float pad_;
    __device__ __forceinline__ void operator()(const f32x4 (&acc)[2][2][4][2], const Unit& u, int wr, int wc, int fr, int fq) const {
        const int row0 = u.pm * BM + wr * 64 + fr, col0 = u.pn * BM + wc * 32 + 8 * fq;
#pragma unroll
        for (int ai = 0; ai < 2; ++ai)
#pragma unroll
            for (int m = 0; m < 4; ++m) {
                const int row = row0 + ai * HALF + m * 16;
                float rs = 0.f; if (GATED) rs = rsqrtf(row_ssq(ssq_in, 16, 4, row, fq) * (1.f / 1024.f) + EPS);
                float sq = 0.f;
#pragma unroll
                for (int bj = 0; bj < 2; ++bj) {
                    const size_t off = (size_t)row * DM + col0 + bj * HALF;
                    const u32x4 hh = *(const u32x4*)(HI + off), ll = *(const u32x4*)(LO + off);
                    float hv[8] = {bflo(hh.x) + bflo(ll.x), bfhi(hh.x) + bfhi(ll.x), bflo(hh.y) + bflo(ll.y), bfhi(hh.y) + bfhi(ll.y),
                                   bflo(hh.z) + bflo(ll.z), bfhi(hh.z) + bfhi(ll.z), bflo(hh.w) + bflo(ll.w), bfhi(hh.w) + bfhi(ll.w)};
                    float av[8] = {acc[ai][bj][m][0][0], acc[ai][bj][m][0][1], acc[ai][bj][m][0][2], acc[ai][bj][m][0][3], acc[ai][bj][m][1][0], acc[ai][bj][m][1][1], acc[ai][bj][m][1][2], acc[ai][bj][m][1][3]};
                    if (GATED) { const u32x4 pp = *(const u32x4*)(PP + off);
                        const float pv[8] = {bflo(pp.x), bfhi(pp.x), bflo(pp.y), bfhi(pp.y), bflo(pp.z), bfhi(pp.z), bflo(pp.w), bfhi(pp.w)};
#pragma unroll
                        for (int e = 0; e < 8; ++e) av[e] = fast_sigmoid(av[e] * rs) * pv[e]; }
                    else {
#pragma unroll
                        for (int e = 0; e < 8; ++e) av[e] *= alpha; }
                    float lo[8];
#pragma unroll
                    for (int e = 0; e < 8; ++e) { hv[e] += av[e]; sq += hv[e] * hv[e]; }
                    u32x4 wh; wh.x = pk2(hv[0], hv[1]); wh.y = pk2(hv[2], hv[3]); wh.z = pk2(hv[4], hv[5]); wh.w = pk2(hv[6], hv[7]);
                    lo[0] = hv[0] - bflo(wh.x); lo[1] = hv[1] - bfhi(wh.x); lo[2] = hv[2] - bflo(wh.y); lo[3] = hv[3] - bfhi(wh.y);
                    lo[4] = hv[4] - bflo(wh.z); lo[5] = hv[5] - bfhi(wh.z); lo[6] = hv[6] - bflo(wh.w); lo[7] = hv[7] - bfhi(wh.w);
                    u32x4 wl; wl.x = pk2(lo[0], lo[1]); wl.y = pk2(lo[2], lo[3]); wl.z = pk2(lo[4], lo[5]); wl.w = pk2(lo[6], lo[7]);
                    *(u32x4*)(HO + off) = wh; *(u32x4*)(LO + off) = wl;
                }
                sq += __shfl_xor(sq, 16); sq += __shfl_xor(sq, 32);
                if (fq == 0) ssq_out[(size_t)row * 16 + 4 * u.pn + wc] = sq;
            }
    }
};
struct EpiGen {
    static constexpr bool PERM = true;
    bf16_t* O; int ldc; const float* ssq_in; float inv_k; int mode; float* ssq_q; float* ssq_kv; const float* rope; int in_pitch; int in_n4;
    __device__ __forceinline__ void operator()(const f32x4 (&acc)[2][2][4][2], const Unit& u, int wr, int wc, int fr, int fq) const {
        const int row0 = u.pm * BM + wr * 64 + fr;
        float rsv[2][4];
#pragma unroll
        for (int ai = 0; ai < 2; ++ai)
#pragma unroll
            for (int m = 0; m < 4; ++m) rsv[ai][m] = ssq_in ? rsqrtf(row_ssq(ssq_in, in_pitch, in_n4, row0 + ai * HALF + m * 16, fq) * inv_k + EPS) : 1.f;
#pragma unroll
        for (int bj = 0; bj < 2; ++bj) {
            const int c0 = u.pn * BM + bj * HALF + wc * 32;
            float scale = 1.f; bool sig = false, rp = false, st = true; float* sq = nullptr; int sqp = 0;
            if (mode == 1) { const int slab = c0 >> 7;
                if (slab < 3) { sq = ssq_q + 4 * slab + wc; sqp = 16; } else if (slab < 5) { sq = ssq_kv + 4 * (slab - 3) + wc; sqp = 8; } else if (slab == 5) { rp = (wc == 0); st = (wc == 0); }
                else if (slab < 14) scale = C2_64; else if (slab < 18) {} else if (slab < 26) scale = C2_64; else if (slab < 42) {} else sig = true;
            } else if (mode == 2) { rp = ((c0 % 96) == 64); scale = C2_96; }
            if (!st) continue;
#pragma unroll
            for (int ai = 0; ai < 2; ++ai)
#pragma unroll
                for (int m = 0; m < 4; ++m) {
                    const int row = row0 + ai * HALF + m * 16; const float rs = rsv[ai][m] * scale;
                    f32x4 v0 = acc[ai][bj][m][0] * rs, v1 = acc[ai][bj][m][1] * rs;
                    if (rp) {
                        const int pos = row & (SEQ - 1); const float* rb = rope + pos * 32 + 8 * (fq & 1); const bool hi2 = (fq >> 1) != 0;
                        const f32x4 cs0 = *(const f32x4*)(rb), cs1 = *(const f32x4*)(rb + 4), sn0 = *(const f32x4*)(rb + 16), sn1 = *(const f32x4*)(rb + 20);
#pragma unroll
                        for (int e = 0; e < 4; ++e) { const float q0 = __shfl_xor(v0[e], 32), q1 = __shfl_xor(v1[e], 32);
                            v0[e] = hi2 ? v0[e] * cs0[e] + q0 * sn0[e] : v0[e] * cs0[e] - q0 * sn0[e];
                            v1[e] = hi2 ? v1[e] * cs1[e] + q1 * sn1[e] : v1[e] * cs1[e] - q1 * sn1[e]; } }
                    if (sig) {
#pragma unroll
                        for (int e = 0; e < 4; ++e) { v0[e] = fast_sigmoid(v0[e]); v1[e] = fast_sigmoid(v1[e]); } }
                    if (sq) { float s = (v0[0] * v0[0] + v0[1] * v0[1]) + (v0[2] * v0[2] + v0[3] * v0[3]) + (v1[0] * v1[0] + v1[1] * v1[1]) + (v1[2] * v1[2] + v1[3] * v1[3]);
                        s += __shfl_xor(s, 16); s += __shfl_xor(s, 32); if (fq == 0) sq[(size_t)row * sqp] = s; }
                    u32x4 w; w.x = pk2(v0[0], v0[1]); w.y = pk2(v0[2], v0[3]); w.z = pk2(v1[0], v1[1]); w.w = pk2(v1[2], v1[3]);
                    *(u32x4*)(O + (size_t)row * ldc + c0 + 8 * fq) = w;
                }
        }
    }
};
}

constexpr int ATT_LUT_OFF = 61440;
template <int DQK, int DV, int MODE, bool RES = false>
__device__ __forceinline__ void flash_core(LAS unsigned char* lds, int wave_s, const bf16_t* Qp, int qpitch, const bf16_t* K1, int k1pitch, const bf16_t* K2, int k2pitch,
                                           const bf16_t* Vp, int vpitch, int q0, int kt_lo, int kt_hi, const LAS float* lut, float sink2, f32x16 (&o)[DV / 32], int win_lo = 0) {
    constexpr int CH = DQK / 8, KS = DQK * 2 + 16, KBUF = 64 * KS, VBUF = 64 * DV * 2, VCH = DV / 8;
    constexpr int NKI = (64 * CH + 511) / 512, NVI = (64 * VCH) / 512, NDB = DV / 32;
    static_assert(RES || 2 * KBUF + 2 * VBUF <= ATT_LUT_OFF, "attention LDS");
    LAS unsigned char* Kl = lds; LAS unsigned char* Vl = lds + (RES ? 8 : 2) * KBUF;
    const int tid = fresh_tid(wave_s);
    const int lane = tid & 63, wid = __builtin_amdgcn_readfirstlane(tid >> 6), r32 = lane & 31, h = lane >> 5;
    bf16x8 qf[DQK / 16];
    { const bf16_t* qrow = Qp + (size_t)(32 * wid + r32) * qpitch + 8 * h;
#pragma unroll
      for (int d0 = 0; d0 < DQK / 16; ++d0) qf[d0] = *(const bf16x8*)(qrow + 16 * d0); }
    float mrun = -INFINITY, lrun = 0.f;
#pragma unroll
    for (int db = 0; db < NDB; ++db)
#pragma unroll
        for (int r = 0; r < 16; ++r) o[db][r] = 0.f;
    const int qw0 = q0 + 32 * wid, qpos = qw0 + r32;
    const bf16x8 ones = (bf16x8){(short)0x3F80, (short)0x3F80, (short)0x3F80, (short)0x3F80, (short)0x3F80, (short)0x3F80, (short)0x3F80, (short)0x3F80};
    u32x4 kreg[NKI], vreg[NVI];
    const unsigned char* ksrc[NKI]; unsigned kstep[NKI]; int kdst[NKI]; bool kval[NKI];
#pragma unroll
    for (int i_ = 0; i_ < NKI; ++i_) { const int idx = tid + 512 * i_; const int key = idx / CH, c = idx % CH; kval[i_] = (idx < 64 * CH);
        if (c < 8) { ksrc[i_] = (const unsigned char*)(K1 + (size_t)key * k1pitch + 8 * c); kstep[i_] = (unsigned)(128 * k1pitch); }
        else       { ksrc[i_] = (const unsigned char*)(K2 + (size_t)key * k2pitch + 8 * (c - 8)); kstep[i_] = (unsigned)(128 * k2pitch); }
        if (!kval[i_]) { ksrc[i_] = (const unsigned char*)K1; kstep[i_] = 0u; }
        kdst[i_] = key * KS + 16 * c; }
    const unsigned char* vsrc0; int vdst0;
    { const int key = tid / VCH, c = tid % VCH; vsrc0 = (const unsigned char*)(Vp + (size_t)key * vpitch + 8 * c); vdst0 = (c >> 2) * 4096 + (key >> 3) * 512 + (key & 7) * 64 + (c & 3) * 16; }
    const unsigned vrowoff = (unsigned)((512 / VCH) * vpitch * 2);
    constexpr int VDSTOFF = ((512 / VCH) >> 3) * 512;
    const unsigned vstep = (unsigned)(128 * vpitch);
#define FA_LOADK(kt) do { _Pragma("unroll") for (int i_ = 0; i_ < NKI; ++i_) kreg[i_] = *(const u32x4*)(ksrc[i_] + (size_t)(unsigned)(kt) * kstep[i_]); } while (0)
#define FA_LOADV(kt) do { _Pragma("unroll") for (int i_ = 0; i_ < NVI; ++i_) vreg[i_] = *(const u32x4*)(vsrc0 + (size_t)(unsigned)(kt) * vstep + (size_t)i_ * vrowoff); } while (0)
#define FA_STOREK(buf) do { _Pragma("unroll") for (int i_ = 0; i_ < NKI; ++i_) { if (kval[i_]) *(LAS u32x4*)(Kl + (buf) * KBUF + kdst[i_]) = kreg[i_]; } } while (0)
#define FA_STOREV(buf) do { _Pragma("unroll") for (int i_ = 0; i_ < NVI; ++i_) *(LAS u32x4*)(Vl + (buf) * VBUF + vdst0 + i_ * VDSTOFF) = vreg[i_]; } while (0)
#define FA_QK(P0, P1, kbuf, CI) do { const LAS unsigned char* kb_ = Kl + (kbuf) * KBUF + r32 * KS + 16 * h; \
    _Pragma("unroll") for (int d0 = 0; d0 < DQK / 16; ++d0) { \
        const bf16x8 a0 = *(const LAS bf16x8*)(kb_ + 32 * d0), a1 = *(const LAS bf16x8*)(kb_ + 32 * KS + 32 * d0); \
        if (d0 == 0) { P0 = __builtin_amdgcn_mfma_f32_32x32x16_bf16(a0, qf[0], CI, 0, 0, 0); P1 = __builtin_amdgcn_mfma_f32_32x32x16_bf16(a1, qf[0], CI, 0, 0, 0); } \
        else { P0 = __builtin_amdgcn_mfma_f32_32x32x16_bf16(a0, qf[d0], P0, 0, 0, 0); P1 = __builtin_amdgcn_mfma_f32_32x32x16_bf16(a1, qf[d0], P1, 0, 0, 0); } } } while (0)
#define SBAR() __builtin_amdgcn_sched_barrier(0)
#define FA_CHUNK(c, p0, p1) do { \
    if ((c) < 4) { ma = max3f(ma, p0[4 * (c)], p0[4 * (c) + 1]); mb = max3f(mb, p0[4 * (c) + 2], p0[4 * (c) + 3]); ma = max3f(ma, p1[4 * (c)], p1[4 * (c) + 1]); mb = max3f(mb, p1[4 * (c) + 2], p1[4 * (c) + 3]); } \
    else if ((c) == 4) { float rm = max2f(ma, mb); { auto rr_ = __builtin_amdgcn_permlane32_swap(__float_as_uint(rm), __float_as_uint(rm), false, false); rm = max2f(__uint_as_float(rr_[0]), __uint_as_float(rr_[1])); } \
        if (NEGM) {   \
            const bool need_ = __any(rm > 5.0f || rm < -40.0f); pendf = need_; pend = 0.f; alpha = 1.f; \
            if (need_) { const float dl_ = (rm > 0.f || rm < -40.0f) ? rm : 0.f; _Pragma("unroll") for (int r_ = 0; r_ < 16; ++r_) { p0[r_] -= dl_; p1[r_] -= dl_; } \
                alpha = __builtin_amdgcn_exp2f(-dl_); mrun += dl_; pend = dl_; } } \
        else { rm += ctile;   \
        const bool need_ = __any(rm > mrun + 5.0f); const float mnew = need_ ? max2f(mrun, rm) : mrun; const float muse = (mnew == -INFINITY) ? 0.f : mnew; alpha = __builtin_amdgcn_exp2f(mrun - muse); mrun = mnew; msub = muse - ctile; } } \
    else if ((c) < 9) { _Pragma("unroll") for (int e_ = 0; e_ < 4; ++e_) p0[4 * ((c) - 5) + e_] = NEGM ? __builtin_amdgcn_exp2f(p0[4 * ((c) - 5) + e_]) : __builtin_amdgcn_exp2f(p0[4 * ((c) - 5) + e_] - msub); \
        asm volatile("" : "+v"(p0[4 * ((c) - 5)]), "+v"(p0[4 * ((c) - 5) + 1]), "+v"(p0[4 * ((c) - 5) + 2]), "+v"(p0[4 * ((c) - 5) + 3])); } \
    else { _Pragma("unroll") for (int e_ = 0; e_ < 4; ++e_) p1[4 * ((c) - 9) + e_] = NEGM ? __builtin_amdgcn_exp2f(p1[4 * ((c) - 9) + e_]) : __builtin_amdgcn_exp2f(p1[4 * ((c) - 9) + e_] - msub); \
        asm volatile("" : "+v"(p1[4 * ((c) - 9)]), "+v"(p1[4 * ((c) - 9) + 1]), "+v"(p1[4 * ((c) - 9) + 2]), "+v"(p1[4 * ((c) - 9) + 3])); } } while (0)
#define FA_GAP(g, p0, p1) do { if ((g) + 1 <= 8) FA_CHUNK((g) + 1, p0, p1); SBAR(); } while (0)
#define FA_KFRAG(d) (*(const LAS bf16x8*)(kb_ + 32 * (d))), (*(const LAS bf16x8*)(kb_ + 32 * KS + 32 * (d)))
#define FA_STEP(p0, p1, SN0, SN1, t) do { const int tt_ = (t) - kt_lo; float ctile = 0.f; \
    if (MODE == 2) { const int tlo = 64 * (t); \
        if (tlo + 63 - qw0 <= -128) { if (!NEGM) ctile = lut[0]; } else if (tlo - (qw0 + 31) >= 128) { if (!NEGM) ctile = lut[511]; } \
        else { const LAS float* lq_ = lut + (tlo + 4 * h - qpos + 256); _Pragma("unroll") for (int r = 0; r < 16; ++r) { p0[r] += lq_[(r & 3) + 8 * (r >> 2)]; p1[r] += lq_[(r & 3) + 8 * (r >> 2) + 32]; } } } \
    if (MODE == 1) { const LAS float* lp_ = lut + (64 * (t) + 4 * h - qpos + 320); \
        _Pragma("unroll") for (int r = 0; r < 16; ++r) { p0[r] += lp_[(r & 3) + 8 * (r >> 2)]; p1[r] += lp_[(r & 3) + 8 * (r >> 2) + 32]; } } \
    if (NEGM) { if (pendf) { _Pragma("unroll") for (int r_ = 0; r_ < 16; ++r_) { p0[r_] -= pend; p1[r_] -= pend; } } \
        float cn_ = 0.f; if (MODE == 2) { const int tl1 = 64 * ((t) + 1); if (tl1 + 63 - qw0 <= -128) cn_ = lut[0]; else if (tl1 - (qw0 + 31) >= 128) cn_ = lut[511]; } \
        const float cb_ = cn_ - mrun; if (__any(cb_ != cbs)) { cbs = cb_; _Pragma("unroll") for (int r_ = 0; r_ < 16; ++r_) negc[r_] = cb_; } } \
    SBAR(); \
      \
    float ma = -INFINITY, mb = -INFINITY, alpha = 1.f, msub = 0.f; \
    bf16x8 vfr[4][NDB]; const LAS unsigned char* vbs_ = Vl + (RES ? ((t) - win_lo) : (tt_ & 1)) * VBUF + vlane; \
    { const LAS unsigned char* kb_ = Kl + (RES ? (min((t) + 1, kt_hi - 1) - win_lo) : ((tt_ + 1) & 1)) * KBUF + r32 * KS + 16 * h; \
      bf16x8 kf[DQK / 16][2]; \
      kf[0][0] = *(const LAS bf16x8*)(kb_); kf[0][1] = *(const LAS bf16x8*)(kb_ + 32 * KS); kf[1][0] = *(const LAS bf16x8*)(kb_ + 32); kf[1][1] = *(const LAS bf16x8*)(kb_ + 32 * KS + 32); \
      if (KD > 2) { kf[2][0] = *(const LAS bf16x8*)(kb_ + 64); kf[2][1] = *(const LAS bf16x8*)(kb_ + 32 * KS + 64); } \
      if (!RES) { FA_LOADK(min((t) + 2, kt_hi - 1)); FA_LOADV(min((t) + 1, kt_hi - 1)); } \
      FA_CHUNK(0, p0, p1); SBAR(); \
      _Pragma("unroll") for (int d0 = 0; d0 < DQK / 16; ++d0) { \
        if (d0 + KD < DQK / 16) { kf[d0 + KD][0] = *(const LAS bf16x8*)(kb_ + 32 * (d0 + KD)); kf[d0 + KD][1] = *(const LAS bf16x8*)(kb_ + 32 * KS + 32 * (d0 + KD)); } \
        if (VPRE && (d0 == 1 || d0 == 2)) { _Pragma("unroll") for (int db = 0; db < NDB; ++db) { const LAS unsigned char* vp = vbs_ + db * 4096 + (d0 - 1) * 1024; \
            const v4i16_t lo = __builtin_amdgcn_ds_read_tr16_b64_v4i16((LAS v4i16_t*)vp); const v4i16_t hi = __builtin_amdgcn_ds_read_tr16_b64_v4i16((LAS v4i16_t*)(vp + 512)); \
            vfr[d0 - 1][db] = (bf16x8){lo[0], lo[1], lo[2], lo[3], hi[0], hi[1], hi[2], hi[3]}; } } \
        if (d0 == 0) SN0 = __builtin_amdgcn_mfma_f32_32x32x16_bf16(kf[0][0], qf[0], NEGM ? negc : zero16, 0, 0, 0); else SN0 = __builtin_amdgcn_mfma_f32_32x32x16_bf16(kf[d0][0], qf[d0], SN0, 0, 0, 0); \
        FA_GAP(2 * d0, p0, p1); \
        if (d0 == 0) SN1 = __builtin_amdgcn_mfma_f32_32x32x16_bf16(kf[0][1], qf[0], NEGM ? negc : zero16, 0, 0, 0); else SN1 = __builtin_amdgcn_mfma_f32_32x32x16_bf16(kf[d0][1], qf[d0], SN1, 0, 0, 0); \
        FA_GAP(2 * d0 + 1, p0, p1); } } \
    if (!__all(alpha == 1.0f)) { _Pragma("unroll") for (int db = 0; db < NDB; ++db) _Pragma("unroll") for (int r = 0; r < 16; ++r) o[db][r] *= alpha; } \
    SBAR(); \
      \
    { f32x16 lacc; u32x4 pw, pwn; \
      pw.x = pk2(p0[0], p0[1]); pw.y = pk2(p0[2], p0[3]); pw.z = pk2(p0[4], p0[5]); pw.w = pk2(p0[6], p0[7]); pwn = pw; \
      if (!VPRE) { _Pragma("unroll") for (int s_ = 0; s_ < 2; ++s_) _Pragma("unroll") for (int db = 0; db < NDB; ++db) { const LAS unsigned char* vp = vbs_ + db * 4096 + s_ * 1024; \
            const v4i16_t lo = __builtin_amdgcn_ds_read_tr16_b64_v4i16((LAS v4i16_t*)vp); const v4i16_t hi = __builtin_amdgcn_ds_read_tr16_b64_v4i16((LAS v4i16_t*)(vp + 512)); \
            vfr[s_][db] = (bf16x8){lo[0], lo[1], lo[2], lo[3], hi[0], hi[1], hi[2], hi[3]}; } } \
      SBAR(); \
      _Pragma("unroll") for (int s4 = 0; s4 < 4; ++s4) { \
        const bf16x8 pb = __builtin_bit_cast(bf16x8, pw); \
        lacc = __builtin_amdgcn_mfma_f32_32x32x16_bf16(ones, pb, (s4 == 0) ? zero16 : lacc, 0, 0, 0); \
        if (s4 == 0) { pwn.x = pk2(p0[8], p0[9]); pwn.y = pk2(p0[10], p0[11]); pwn.z = pk2(p0[12], p0[13]); pwn.w = pk2(p0[14], p0[15]); } \
        if (s4 == 1) { pwn.x = pk2(p1[0], p1[1]); pwn.y = pk2(p1[2], p1[3]); pwn.z = pk2(p1[4], p1[5]); pwn.w = pk2(p1[6], p1[7]); } \
        if (s4 == 2) { pwn.x = pk2(p1[8], p1[9]); pwn.y = pk2(p1[10], p1[11]); pwn.z = pk2(p1[12], p1[13]); pwn.w = pk2(p1[14], p1[15]); } \
        SBAR(); \
        _Pragma("unroll") for (int db = 0; db < NDB; ++db) { \
            o[db] = __builtin_amdgcn_mfma_f32_32x32x16_bf16(vfr[s4][db], pb, o[db], 0, 0, 0); \
            if (s4 < 2) { const LAS unsigned char* vp = vbs_ + db * 4096 + (s4 + 2) * 1024; \
                const v4i16_t lo = __builtin_amdgcn_ds_read_tr16_b64_v4i16((LAS v4i16_t*)vp); const v4i16_t hi = __builtin_amdgcn_ds_read_tr16_b64_v4i16((LAS v4i16_t*)(vp + 512)); \
                vfr[s4 + 2][db] = (bf16x8){lo[0], lo[1], lo[2], lo[3], hi[0], hi[1], hi[2], hi[3]}; } \
            if (s4 < 2 && db >= NDB - 2) FA_CHUNK(9 + 2 * s4 + (db - (NDB - 2)), p0, p1); \
            SBAR(); } \
        pw = pwn; } \
      lrun = lrun * alpha + lacc[0]; } \
    if (!RES) { FA_STOREK(tt_ & 1); FA_STOREV((tt_ + 1) & 1); __syncthreads(); } } while (0)
    const int vlane = (4 * h + ((lane & 15) >> 2)) * 64 + ((lane >> 4) & 1) * 32 + (lane & 3) * 8;
    f32x16 zero16;
#pragma unroll
    for (int r = 0; r < 16; ++r) zero16[r] = 0.f;
    f32x16 pA0 = zero16, pA1 = zero16, pB0 = zero16, pB1 = zero16;
    constexpr bool VPRE = (DV <= 64); constexpr int KD = (DV <= 64) ? 3 : 2;
    constexpr bool NEGM = (MODE != 1);
    f32x16 negc = zero16; float cbs = 0.f, pend = 0.f; bool pendf = false;
    if (NEGM) mrun = 0.f;
    if (!RES) {
        u32x4 k2_[NKI];
        FA_LOADK(kt_lo); FA_LOADV(kt_lo);
#pragma unroll
        for (int i_ = 0; i_ < NKI; ++i_) k2_[i_] = *(const u32x4*)(ksrc[i_] + (size_t)(unsigned)(kt_lo + 1) * kstep[i_]);
        FA_STOREK(0); FA_STOREV(0);
#pragma unroll
        for (int i_ = 0; i_ < NKI; ++i_) { if (kval[i_]) *(LAS u32x4*)(Kl + KBUF + kdst[i_]) = k2_[i_]; }
        __syncthreads();
        if (NEGM) { if (MODE == 2) {     const int tl0 = 64 * kt_lo; float c0_ = 0.f; if (tl0 + 63 - qw0 <= -128) c0_ = lut[0]; else if (tl0 - (qw0 + 31) >= 128) c0_ = lut[511]; cbs = c0_;
#pragma unroll
        for (int r_ = 0; r_ < 16; ++r_) negc[r_] = c0_; } }
        FA_QK(pA0, pA1, 0, negc);
        __syncthreads();
    } else {
        FA_QK(pA0, pA1, kt_lo - win_lo, zero16);
    }
    for (int kt = kt_lo; kt < kt_hi; kt += 2) {
        FA_STEP(pA0, pA1, pB0, pB1, kt);
        FA_STEP(pB0, pB1, pA0, pA1, kt + 1);
    }
#undef SBAR
#undef FA_CHUNK
#undef FA_KFRAG
#undef FA_GAP
#undef FA_LOADK
#undef FA_LOADV
#undef FA_STOREK
#undef FA_STOREV
#undef FA_QK
#undef FA_STEP
    float lt = lrun;
    if (MODE == 1) lt += __builtin_amdgcn_exp2f(sink2 - mrun);
    const float inv = 1.f / lt;
#pragma unroll
    for (int db = 0; db < NDB; ++db)
#pragma unroll
        for (int r = 0; r < 16; ++r) o[db][r] *= inv;
}

template <int DV, bool ACCUM>
__device__ __forceinline__ void attn_store(const f32x16 (&o)[DV / 32], const bf16_t* gate_row, bf16_t* merged_row, int h) {
#pragma unroll
    for (int db = 0; db < DV / 32; ++db)
#pragma unroll
        for (int rg = 0; rg < 4; ++rg) {
            const int d = 32 * db + 8 * rg + 4 * h;
            const u32x2 g = *(const u32x2*)(gate_row + d);
            float v0 = o[db][4 * rg + 0] * bflo(g.x), v1 = o[db][4 * rg + 1] * bfhi(g.x), v2 = o[db][4 * rg + 2] * bflo(g.y), v3 = o[db][4 * rg + 3] * bfhi(g.y);
            if (ACCUM) { const u32x2 mm = *(const u32x2*)(merged_row + d); v0 += bflo(mm.x); v1 += bfhi(mm.x); v2 += bflo(mm.y); v3 += bfhi(mm.y); }
            u32x2 w; w.x = pk2(v0, v1); w.y = pk2(v2, v3);
            *(u32x2*)(merged_row + d) = w;
            if (rg == 3) __builtin_amdgcn_sched_barrier(0);
        }
}

__device__ __forceinline__ void build_lut(LAS float* lut, const float* rel_table, int col, int wave_s) {
    const int tid = fresh_tid(wave_s);
    if (tid < 257) {
        const int rel = tid - 128, n = rel < 0 ? -rel : rel, base = rel > 0 ? 16 : 0; int bkt;
        if (n < 8) bkt = n; else { const unsigned t = (unsigned)(n * n) >> 6; const int k = 31 - __clz((int)t); bkt = min(8 + k, 15); }
        lut[tid] = rel_table[(base + bkt) * 24 + col] * LOG2E;
    }
}

__device__ __forceinline__ void build_lut_dense(LAS float* lut, const float* rel_table, int col, int wave_s) {
    const int tid = fresh_tid(wave_s);
    { const int rel = tid - 256, n = rel < 0 ? -rel : rel, base = rel > 0 ? 16 : 0; int bkt;
      if (n < 8) bkt = n; else { const unsigned t = (unsigned)(n * n) >> 6; const int k = 31 - __clz((int)t); bkt = min(8 + k, 15); }
      lut[tid] = rel_table[(base + bkt) * 24 + col] * LOG2E; }
}

__device__ __forceinline__ void build_lut_pad(LAS float* lut, const float* rel_table, int col, int wave_s) {
    const int tid = fresh_tid(wave_s);
    for (int i = tid; i < 640; i += 512) {
        const int rel = i - 320, n = rel < 0 ? -rel : rel, base = rel > 0 ? 16 : 0; int bkt;
        if (n < 8) bkt = n; else { const unsigned t = (unsigned)(n * n) >> 6; const int k = 31 - __clz((int)t); bkt = min(8 + k, 15); }
        lut[i] = (n <= 128) ? rel_table[(base + bkt) * 24 + col] * LOG2E : -INFINITY;
    }
}

typedef unsigned gu32_t;
#define RLX_AGENT __ATOMIC_RELAXED, __HIP_MEMORY_SCOPE_AGENT
#define XB_TMO      128
#define XB_XCNT(j)  (256  + 64 * (j))
#define XB_XSUB(j)  (1280 + 64 * (j))
#define XB_XGEN(j)  (2304 + 64 * (j))
#define XB_TOP      3328
#define XB_TOPGEN   3392
#define XCD_BAR_WORDS 3456
#define XB_SPIN_CAP (1u << 18)

__device__ __forceinline__ unsigned xb_ld(unsigned* p)              { return __hip_atomic_load(p, __ATOMIC_RELAXED, __HIP_MEMORY_SCOPE_AGENT); }
__device__ __forceinline__ unsigned xb_add(unsigned* p, unsigned v) { return __hip_atomic_fetch_add(p, v, __ATOMIC_RELAXED, __HIP_MEMORY_SCOPE_AGENT); }
__device__ __forceinline__ unsigned xb_xcc_id() { return (unsigned)__builtin_amdgcn_s_getreg((3 << 11) | 20) & 0xFu; }
#define XB_SPIN(cond, bar) do { unsigned _sp = 0; while (cond) { __builtin_amdgcn_s_sleep(1); \
    if ((++_sp & 255u) == 0u) { if (xb_ld(&(bar)[XB_TMO])) break; if (_sp > XB_SPIN_CAP) { atomicAdd(&(bar)[XB_TMO], 1u); break; } } } } while (0)

struct XcdBarrier {
    unsigned* bar; unsigned x;
    volatile LAS unsigned* st;
};

__device__ __forceinline__ XcdBarrier xcd_barrier_post(unsigned* bar, volatile LAS unsigned* st) {
    XcdBarrier b; b.bar = bar; b.x = xb_xcc_id(); b.st = st;
    if (threadIdx.x == 0) (void)xb_add(&bar[XB_XCNT(b.x)], 1u);
    return b;
}
__device__ __forceinline__ void xcd_barrier_complete(unsigned* bar, unsigned x, unsigned& nloc, unsigned& nx) {
    const unsigned G = gridDim.x * gridDim.y * gridDim.z;
    unsigned sum, cnt, mine, sp = 0u;
    for (;;) {
        sum = 0u; cnt = 0u; mine = 0u;
#pragma unroll
        for (unsigned j = 0; j < 16; ++j) { const unsigned c = xb_ld(&bar[XB_XCNT(j)]); sum += c; cnt += (c > 0u) ? 1u : 0u; mine = (j == x) ? c : mine; }
        if (sum == G) break;
        __builtin_amdgcn_s_sleep(1);
        if ((++sp & 255u) == 0u) { if (xb_ld(&bar[XB_TMO])) break; if (sp > XB_SPIN_CAP) { atomicAdd(&bar[XB_TMO], 1u); break; } }
    }
    nloc = mine > 0u ? mine : 1u; nx = cnt > 0u ? cnt : 1u;
}

__device__ __forceinline__ void xcd_barrier(const XcdBarrier& b) {
    asm volatile("s_waitcnt vmcnt(0)" ::: "memory");
    __syncthreads();
    if (threadIdx.x == 0) {
        unsigned* bar = b.bar;
        __builtin_amdgcn_s_waitcnt(0);
        unsigned nloc = b.st[0], nx = b.st[1];
        if (nloc == 0u) { xcd_barrier_complete(bar, b.x, nloc, nx); b.st[0] = nloc; b.st[1] = nx; }
        const unsigned old = xb_add(&bar[XB_XSUB(b.x)], 1u);
        const unsigned gen = old / nloc;
        if (old + 1u == (gen + 1u) * nloc) {
            __builtin_amdgcn_fence(__ATOMIC_RELEASE, "agent");
            asm volatile("s_waitcnt vmcnt(0)" ::: "memory");
            const unsigned og = xb_add(&bar[XB_TOP], 1u);
            const unsigned tg = og / nx;
            if (og + 1u == (tg + 1u) * nx) xb_add(&bar[XB_TOPGEN], 1u);
            else XB_SPIN(xb_ld(&bar[XB_TOPGEN]) == tg, bar);
            __builtin_amdgcn_fence(__ATOMIC_ACQUIRE, "agent");
            xb_add(&bar[XB_XGEN(b.x)], 1u);
            asm volatile("s_waitcnt vmcnt(0)" ::: "memory");
        } else {
            XB_SPIN(xb_ld(&bar[XB_XGEN(b.x)]) == gen, bar);
            __builtin_amdgcn_fence(__ATOMIC_ACQUIRE, "agent");
            asm volatile("s_waitcnt vmcnt(0)" ::: "memory");
        }
    }
    __syncthreads();
}


struct Args { const float* in[28]; float* out; unsigned char* ws; };

__device__ __forceinline__ void conv_item(const float* W, int K, int N, const float* gain, bf16_t* WT, int dst_row0, LAS float* scr, int kb, int n0, int lane) {
    const int k0 = 64 * kb;
    float v[32];
    const float* wp = W + (size_t)(k0 + (lane >> 5)) * N + n0 + (lane & 31);
#pragma unroll
    for (int i = 0; i < 32; ++i) v[i] = wp[(size_t)(2 * i) * N];
    if (gain) {
#pragma unroll
        for (int i = 0; i < 32; ++i) v[i] *= gain[k0 + 2 * i + (lane >> 5)];
    }
#pragma unroll
    for (int i = 0; i < 32; ++i) scr[(2 * i + (lane >> 5)) * 33 + (lane & 31)] = v[i];
    asm volatile("s_waitcnt lgkmcnt(0)" ::: "memory");
    const int c = lane & 7;
#pragma unroll
    for (int j = 0; j < 4; ++j) { const int n = (lane >> 3) + 8 * j; const LAS float* s = scr + (8 * c) * 33 + n;
        u32x4 o; o.x = pk2(s[0 * 33], s[1 * 33]); o.y = pk2(s[2 * 33], s[3 * 33]); o.z = pk2(s[4 * 33], s[5 * 33]); o.w = pk2(s[6 * 33], s[7 * 33]);
        *(u32x4*)(WT + (size_t)(dst_row0 + n) * K + k0 + 8 * c) = o; }
    asm volatile("s_waitcnt lgkmcnt(0)" ::: "memory");
}

__global__ void __launch_bounds__(512) fwd_megakernel(Args a) {
    extern __shared__ __attribute__((aligned(16))) unsigned char lds_raw[];
    LAS unsigned char* lds = (LAS unsigned char*)lds_raw;
    cg::grid_group grid = cg::this_grid();
#define GSYNC() do { asm volatile("s_waitcnt vmcnt(0) lgkmcnt(0)" ::: "memory"); __syncthreads(); grid.sync(); } while (0)
    { volatile LAS unsigned* st0 = (volatile LAS unsigned*)(lds + 147456 - 64); if (threadIdx.x < 16) st0[threadIdx.x] = 0u; }
    __syncthreads();
    const XcdBarrier xbar = xcd_barrier_post((unsigned*)(a.ws + WS_BAR), (volatile LAS unsigned*)(lds + 147456 - 64));
#define XSYNC() do { asm volatile("s_waitcnt vmcnt(0) lgkmcnt(0)" ::: "memory"); xcd_barrier(xbar); } while (0)
    const int wave_s = __builtin_amdgcn_readfirstlane(threadIdx.x >> 6);
    const int G = gridDim.x, bx = blockIdx.x, vcu = (G % 8 == 0) ? (bx % 8) * (G / 8) + bx / 8 : bx;
    const int NGW = G * 8;
#define FRESH_IDS const int tid = fresh_tid(wave_s); const int lane = tid & 63, wave = wave_s, gw = vcu * 8 + wave; (void)lane; (void)gw; (void)tid;
    unsigned char* ws = a.ws;
    float* PH0 = (float*)(ws + WS_PH0); float* PH1 = (float*)(ws + WS_PH1); float* PH2 = (float*)(ws + WS_PH2); float* PH3 = (float*)(ws + WS_PH3);
    float* PQ = (float*)(ws + WS_PQ); float* PKV = (float*)(ws + WS_PKV);
    float* rope = (float*)(ws + WS_ROPE);
    bf16_t* Wb = (bf16_t*)(ws + WS_W);
    bf16_t* PB = (bf16_t*)(ws + WS_PB);
    bf16_t* HB = (bf16_t*)(ws + WS_HB);
    bf16_t* ACT = (bf16_t*)(ws + WS_ACT);
    bf16_t* QA = (bf16_t*)(ws + WS_QA);
    bf16_t* KVA = (bf16_t*)(ws + WS_KVA);
    bf16_t* HID = (bf16_t*)(ws + WS_HID);
    bf16_t* PPJ = (bf16_t*)(ws + WS_PPJ);
    float* Hf = a.out;
    bf16_t* LOP = (bf16_t*)((unsigned char*)a.out + (size_t)128 * MiB);
    const float* rel_table = a.in[18];

    {
        FRESH_IDS
        const float* x = a.in[0];
        for (int m = gw; m < MTOK; m += NGW) {
            const f32x4* xr = (const f32x4*)(x + (size_t)m * DM) + lane; u32x2* l8 = (u32x2*)(LOP + (size_t)m * DM) + lane;
            u32x2* o8 = (u32x2*)(HB + (size_t)m * DM) + lane; float s = 0.f;
#pragma unroll
            for (int j = 0; j < 4; ++j) { const f32x4 v = xr[64 * j]; s += (v[0] * v[0] + v[1] * v[1]) + (v[2] * v[2] + v[3] * v[3]); u32x2 w; w.x = pk2(v[0], v[1]); w.y = pk2(v[2], v[3]); o8[64 * j] = w;
                u32x2 wl; wl.x = pk2(v[0] - bflo(w.x), v[1] - bfhi(w.x)); wl.y = pk2(v[2] - bflo(w.y), v[3] - bfhi(w.y)); l8[64 * j] = wl; }
            s = wave_sum(s); if (lane < 16) PH0[(size_t)m * 16 + lane] = (lane == 0) ? s : 0.f;
        }
        const int gt = gw * 64 + lane, NGT = NGW * 64;
        { u32x4* z = (u32x4*)(Wb + W_IN + (size_t)672 * DM); for (int i = gt; i < 96 * DM / 8; i += NGT) z[i] = (u32x4){0u, 0u, 0u, 0u}; }
        for (int i = gt; i < SEQ * 16; i += NGT) { const int pos = i >> 4, k = i & 15; const float inv = exp2f(-(float)k * 0.8304820237218406f); const float ang = (float)pos * inv;
            float r = ang * 0.15915494309189535f; r = r - floorf(r); rope[pos * 32 + k] = __builtin_amdgcn_cosf(r); rope[pos * 32 + 16 + k] = __builtin_amdgcn_sinf(r); }
    }

#pragma nounroll
    for (int L = 0; L < DEPTH; ++L) {
        {
            FRESH_IDS
            LAS float* scr = (LAS float*)(lds + wave * 16384);
            const float* g_ffn1 = a.in[2] + (size_t)L * DM; const float* g_mix = a.in[6] + (size_t)L * DM; const float* g_q = a.in[8] + (size_t)L * 384; const float* g_kv = a.in[10] + (size_t)L * 256;
            const float* g_ffn2 = a.in[20] + (size_t)L * DM; const float* g_ple = a.in[24] + (size_t)L * DM;
            const float* w_g1 = a.in[3] + (size_t)L * DM * DFF; const float* w_u1 = a.in[4] + (size_t)L * DM * DFF; const float* w_d1 = a.in[5] + (size_t)L * DFF * DM;
            const float* w_in = a.in[7] + (size_t)L * DM * INW; const float* w_uq = a.in[9] + (size_t)L * 384 * QAW; const float* w_ukv = a.in[11] + (size_t)L * 256 * KVAW;
            const float* w_out = a.in[19] + (size_t)L * DM * DM;
            const float* w_g2 = a.in[21] + (size_t)L * DM * DFF; const float* w_u2 = a.in[22] + (size_t)L * DM * DFF; const float* w_d2 = a.in[23] + (size_t)L * DFF * DM;
            const float* w_pg = a.in[25] + (size_t)L * DM * DM; const float* w_pp = a.in[26] + (size_t)L * PLE * DM;
            constexpr int I_G = 16 * 88, I_D = 44 * 32, I_IN = 16 * 261, I_UQ = 6 * 48, I_UKV = 4 * 64, I_SQ = 16 * 32, I_PP = 4 * 32;
            constexpr int NITEMS = 4 * I_G + 2 * I_D + I_IN + I_UQ + I_UKV + 2 * I_SQ + I_PP;
#define CONV_MAT(CNT, W_, K_, N_, G_, DST_, MAPEXPR) if (r < (CNT)) { const int nblk = (N_) / 32, kb = r / nblk, n0 = (r % nblk) * 32; conv_item(W_, K_, N_, G_, DST_, (MAPEXPR), scr, kb, n0, lane); continue; } r -= (CNT);
            for (int it = gw; it < NITEMS; it += NGW) {
                int r = it;
                CONV_MAT(I_G, w_g1, DM, DFF, g_ffn1, Wb + W_GU1, (n0 >> 7) * 256 + (n0 & 127))
                CONV_MAT(I_G, w_u1, DM, DFF, g_ffn1, Wb + W_GU1, (n0 >> 7) * 256 + 128 + (n0 & 127))
                CONV_MAT(I_D, w_d1, DFF, DM, (const float*)nullptr, Wb + W_D1, n0)
                CONV_MAT(I_IN, w_in, DM, INW, g_mix, Wb + W_IN, (n0 < 672 ? n0 : n0 + 96))
                CONV_MAT(I_UQ, w_uq, 384, QAW, g_q, Wb + W_UQ, n0)
                CONV_MAT(I_UKV, w_ukv, 256, KVAW, g_kv, Wb + W_UKV, n0)
                CONV_MAT(I_SQ, w_out, DM, DM, (const float*)nullptr, Wb + W_OUT, n0)
                CONV_MAT(I_G, w_g2, DM, DFF, g_ffn2, Wb + W_GU2, (n0 >> 7) * 256 + (n0 & 127))
                CONV_MAT(I_G, w_u2, DM, DFF, g_ffn2, Wb + W_GU2, (n0 >> 7) * 256 + 128 + (n0 & 127))
                CONV_MAT(I_D, w_d2, DFF, DM, (const float*)nullptr, Wb + W_D2, n0)
                CONV_MAT(I_SQ, w_pg, DM, DM, g_ple, Wb + W_PG, n0)
                CONV_MAT(I_PP, w_pp, PLE, DM, (const float*)nullptr, Wb + W_PP, n0)
            }
#undef CONV_MAT
            const int gt = gw * 64 + lane, NGT = NGW * 64;
            { const f32x4* ps = (const f32x4*)(a.in[1] + (size_t)L * MTOK * PLE); u32x4* pd = (u32x4*)PB;
              constexpr int PTOT = MTOK * PLE / 8; int i = gt;
              for (; i + NGT < PTOT; i += 2 * NGT) { const f32x4 a0 = ps[2 * i], a1 = ps[2 * i + 1], b0 = ps[2 * (i + NGT)], b1 = ps[2 * (i + NGT) + 1];
                  u32x4 wa, wb; wa.x = pk2(a0[0], a0[1]); wa.y = pk2(a0[2], a0[3]); wa.z = pk2(a1[0], a1[1]); wa.w = pk2(a1[2], a1[3]);
                  wb.x = pk2(b0[0], b0[1]); wb.y = pk2(b0[2], b0[3]); wb.z = pk2(b1[0], b1[1]); wb.w = pk2(b1[2], b1[3]); pd[i] = wa; pd[i + NGT] = wb; }
              if (i < PTOT) { const f32x4 v0 = ps[2 * i], v1 = ps[2 * i + 1]; u32x4 w; w.x = pk2(v0[0], v0[1]); w.y = pk2(v0[2], v0[3]); w.z = pk2(v1[0], v1[1]); w.w = pk2(v1[2], v1[3]); pd[i] = w; } }
        }
        if (L == 0) GSYNC(); else XSYNC();

        float* ssq0 = PH0; float* ssq1 = PH1; float* ssq2 = PH2; float* ssq3 = PH3; float* ssq4 = PH0;

        { pg8::Gemm g{(L == 0) ? HB : (const bf16_t*)QA, Wb + W_GU1, MTOK, 2 * DFF, DM, DM}; pg8::StaticOrder S; S.init(MTOK, 2 * DFF, G, bx);
          pg8::EpiSwiglu E{HID, ssq0}; pg8::gemm_phase(lds, wave_s, g, S, E); }
        XSYNC();
        { pg8::Gemm g{HID, Wb + W_D1, MTOK, DM, DFF, DFF}; pg8::StaticOrder S; S.init(MTOK, DM, G, bx);
          pg8::EpiResid<false> E{(L == 0) ? HB : (const bf16_t*)QA, HB, LOP, ssq1, nullptr, nullptr, 0.5f, 0.f}; pg8::gemm_phase(lds, wave_s, g, S, E); }
        XSYNC();

#pragma nounroll
        for (int ck = 0; ck < NCHUNK; ++ck) {
            const size_t r0 = (size_t)ck * MC;
            { pg8::Gemm g{HB + r0 * DM, Wb + W_IN, MC, INP, DM, DM}; pg8::StaticOrder S; S.init(MC, INP, G, bx);
              pg8::EpiGen E{ACT, INP, ssq1 + r0 * 16, 1.f / 1024.f, 1, PQ, PKV, rope, 16, 4}; pg8::gemm_phase(lds, wave_s, g, S, E); }
            XSYNC();
            { pg8::Gemm g{ACT + C_CQ, Wb + W_UQ, MC, QAW, 384, INP}; pg8::StaticOrder S; S.init(MC, QAW, G, bx);
              pg8::EpiGen E{QA, QAW, PQ, 1.f / 384.f, 2, nullptr, nullptr, rope, 16, 3}; pg8::gemm_phase(lds, wave_s, g, S, E); }
            { pg8::Gemm g{ACT + C_CKV, Wb + W_UKV, MC, KVAW, 256, INP}; pg8::StaticOrder S; S.init(MC, KVAW, G, bx);
              pg8::EpiGen E{KVA, KVAW, PKV, 1.f / 256.f, 0, nullptr, nullptr, rope, 8, 2}; pg8::gemm_phase(lds, wave_s, g, S, E); }
            XSYNC();
            {
            FRESH_IDS
            for (int u = vcu; u < NB_CHUNK * 16 * 8; u += G) {
                const int qb = u & 7, hh = (u >> 3) & 15, b = u >> 7; const size_t tok0 = (size_t)b * SEQ;
                f32x16 o[2];
                flash_core<96, 64, 0>(lds, wave_s, QA + (tok0 + 256 * qb) * QAW + 96 * hh, QAW, KVA + tok0 * KVAW + 128 * hh, KVAW, ACT + tok0 * INP + C_KR, INP,
                                      KVA + tok0 * KVAW + 128 * hh + 64, KVAW, 256 * qb, 0, SEQ / 64, (const LAS float*)(lds + ATT_LUT_OFF), 0.f, o);
                const int l2 = fresh_tid(wave_s) & 63;
                bf16_t* row = ACT + (tok0 + 256 * qb + 32 * wave + (l2 & 31)) * INP + C_GA + 64 * hh;
                attn_store<64, false>(o, row, row, l2 >> 5);
            }
            }
            XSYNC();
            {
            FRESH_IDS
            constexpr int SW_KBUF = 64 * 144, SW_VBUF = 8192, SW_LUT = 8 * SW_KBUF + 8 * SW_VBUF;
            for (int u = vcu; u < NB_CHUNK * 4 * 8; u += G) {
                const int qb = u & 7, kvh = (u >> 3) & 3, b = u >> 5; const size_t tok0 = (size_t)b * SEQ;
                const int q0 = 256 * qb; const int klo = max(0, (q0 - 128) >> 6), khi = min(SEQ / 64, (q0 + 384) >> 6);
                __syncthreads();
                { const int t2 = fresh_tid(wave_s); const int key = t2 >> 3, c = t2 & 7;
                  const bf16_t* kp = ACT + (tok0 + 64 * klo + key) * INP + C_KB + 64 * kvh + 8 * c; const bf16_t* vp = ACT + (tok0 + 64 * klo + key) * INP + C_VB + 64 * kvh + 8 * c;
                  LAS unsigned char* kd = lds + key * 144 + 16 * c; LAS unsigned char* vd = lds + 8 * SW_KBUF + (c >> 2) * 4096 + (key >> 3) * 512 + (key & 7) * 64 + (c & 3) * 16;
                  for (int i = 0; i < khi - klo; i += 2) {
                      const u32x4 k0 = *(const u32x4*)(kp + (size_t)(64 * i) * INP), v0 = *(const u32x4*)(vp + (size_t)(64 * i) * INP);
                      const u32x4 k1 = *(const u32x4*)(kp + (size_t)(64 * (i + 1)) * INP), v1 = *(const u32x4*)(vp + (size_t)(64 * (i + 1)) * INP);
                      *(LAS u32x4*)(kd + i * SW_KBUF) = k0; *(LAS u32x4*)(vd + i * SW_VBUF) = v0; *(LAS u32x4*)(kd + (i + 1) * SW_KBUF) = k1; *(LAS u32x4*)(vd + (i + 1) * SW_VBUF) = v1; } }
                const int qw0 = q0 + 32 * wave; int wlo = max(klo, (qw0 - 128) >> 6), whi = min(khi, ((qw0 + 159) >> 6) + 1);
                if ((whi - wlo) & 1) { if (whi < khi) ++whi; else --wlo; }
#pragma nounroll
                for (int g = 0; g < 4; ++g) {
                    const int hh = 4 * kvh + g;
                    __syncthreads();
                    build_lut_pad((LAS float*)(lds + SW_LUT), rel_table, hh, wave_s);
                    __syncthreads();
                    const float sink2 = a.in[12][L * 16 + hh] * LOG2E;
                    f32x16 o[2];
                    flash_core<64, 64, 1, true>(lds, wave_s, ACT + (tok0 + q0) * INP + C_QB + 64 * hh, INP, nullptr, 0, nullptr, 0, nullptr, 0, q0, wlo, whi,
                                                (const LAS float*)(lds + SW_LUT), sink2, o, klo);
                    const int l2 = fresh_tid(wave_s) & 63;
                    bf16_t* row = ACT + (tok0 + q0 + 32 * wave + (l2 & 31)) * INP;
                    attn_store<64, true>(o, row + C_GB + 64 * hh, row + C_GA + 64 * hh, l2 >> 5);
                }
            }
            }
            XSYNC();
            {
                FRESH_IDS
                int Lv = L; asm volatile("" : "+s"(Lv));
                const unsigned lib = (Lv == 0) ? __float_as_uint(0.2f) : (Lv == 1) ? __float_as_uint(0.35550906759096926f) : (Lv == 2) ? __float_as_uint(0.47071301834358416f) : __float_as_uint(0.5560582041556405f);
                const unsigned omb = (Lv == 0) ? __float_as_uint(0.8f) : (Lv == 1) ? __float_as_uint(0.64449093240903074f) : (Lv == 2) ? __float_as_uint(0.52928698165641584f) : __float_as_uint(0.4439417958443595f);
                const float lambda_init = __uint_as_float(lib);
                float s1 = 0.f, s2 = 0.f;
                for (int k_ = 0; k_ < 64; ++k_) { s1 += a.in[13][Lv * 64 + k_] * a.in[14][Lv * 64 + k_]; s2 += a.in[15][Lv * 64 + k_] * a.in[16][Lv * 64 + k_]; }
                const float lam = uniformf(expf(s1) - expf(s2) + lambda_init);
                const float* subln = a.in[17] + Lv * 128;
                float* scr_blk = (float*)(ws + WS_SCR) + (size_t)bx * (64 * 512);
                for (int u = vcu; u < NB_CHUNK * 8 * 8; u += G) {
                    const int qb = u & 7, hh = (u >> 3) & 7, b = u >> 6; const size_t tok0 = (size_t)b * SEQ; const int q0 = 256 * qb;
                    LAS float* lut = (LAS float*)(lds + ATT_LUT_OFF);
                    build_lut_dense(lut, rel_table, 16 + hh, wave_s);
                    { int Lw = Lv; asm volatile("" : "+s"(Lw));
                      const unsigned ob_ = (Lw == 0) ? __float_as_uint(0.8f) : (Lw == 1) ? __float_as_uint(0.64449093240903074f) : (Lw == 2) ? __float_as_uint(0.52928698165641584f) : __float_as_uint(0.4439417958443595f);
                      if (lane_id() == 0) ((LAS unsigned*)lut)[520] = ob_; }
                    f32x16 o[4];
                    flash_core<64, 128, 2>(lds, wave_s, ACT + (tok0 + q0) * INP + C_QC + 128 * hh, INP, ACT + tok0 * INP + C_KC + 128 * hh, INP, nullptr, 0,
                                           ACT + tok0 * INP + C_VC + 128 * hh, INP, q0, 0, SEQ / 64, lut, 0.f, o);
                    { f32x4* scr = (f32x4*)(scr_blk + (size_t)fresh_tid(wave_s) * 64);
#pragma unroll
                    for (int db = 0; db < 4; ++db)
#pragma unroll
                        for (int j = 0; j < 4; ++j) scr[db * 4 + j] = (f32x4){o[db][4 * j], o[db][4 * j + 1], o[db][4 * j + 2], o[db][4 * j + 3]}; }
                    flash_core<64, 128, 2>(lds, wave_s, ACT + (tok0 + q0) * INP + C_QC + 128 * hh + 64, INP, ACT + tok0 * INP + C_KC + 128 * hh + 64, INP, nullptr, 0,
                                           ACT + tok0 * INP + C_VC + 128 * hh, INP, q0, 0, SEQ / 64, lut, 0.f, o);
                    float ss = 0.f;
                    const int t3 = fresh_tid(wave_s), l3 = t3 & 63;
                    const f32x4* scr = (const f32x4*)(scr_blk + (size_t)t3 * 64);
#pragma unroll
                    for (int db = 0; db < 4; ++db)
                    {
#pragma unroll
                      for (int j = 0; j < 4; ++j) { const f32x4 t4 = scr[db * 4 + j];
#pragma unroll
                            for (int e = 0; e < 4; ++e) { const float v = t4[e] - lam * o[db][4 * j + e]; o[db][4 * j + e] = v; ss += v * v; } }
                      __builtin_amdgcn_sched_barrier(0); }
                    ss += __shfl_xor(ss, 32);
                    const float rs = rsqrtf(ss * (1.f / 128.f) + EPS) * lut[520];
                    const int hl = l3 >> 5;
#pragma unroll
                    for (int db = 0; db < 4; ++db)
                    {
#pragma unroll
                      for (int rg = 0; rg < 4; ++rg) { const f32x4 gn = *(const f32x4*)(subln + 32 * db + 8 * rg + 4 * hl);
#pragma unroll
                            for (int e = 0; e < 4; ++e) o[db][4 * rg + e] *= rs * gn[e]; }
                      __builtin_amdgcn_sched_barrier(0); }
                    bf16_t* row = ACT + (tok0 + q0 + 32 * wave + (l3 & 31)) * INP;
                    attn_store<128, true>(o, row + C_GC + 128 * hh, row + C_GA + 128 * hh, hl);
                }
            }
            XSYNC();
            { pg8::Gemm g{ACT + C_GA, Wb + W_OUT, MC, DM, DM, INP}; pg8::StaticOrder S; S.init(MC, DM, G, bx);
              pg8::EpiResid<false> E{HB + r0 * DM, HB + r0 * DM, LOP + r0 * DM, ssq2 + r0 * 16, nullptr, nullptr, 1.0f, 0.f}; pg8::gemm_phase(lds, wave_s, g, S, E); }
            XSYNC();
        }
        { pg8::Gemm g{HB, Wb + W_GU2, MTOK, 2 * DFF, DM, DM}; pg8::StaticOrder S; S.init(MTOK, 2 * DFF, G, bx);
          pg8::EpiSwiglu E{HID, ssq2}; pg8::gemm_phase(lds, wave_s, g, S, E); }
        { pg8::Gemm g{PB, Wb + W_PP, MTOK, DM, PLE, PLE}; pg8::StaticOrder S; S.init(MTOK, DM, G, bx);
          pg8::EpiGen E{PPJ, DM, nullptr, 0.f, 0, nullptr, nullptr, rope, 16, 0}; pg8::gemm_phase(lds, wave_s, g, S, E); }
        XSYNC();
        { pg8::Gemm g{HID, Wb + W_D2, MTOK, DM, DFF, DFF}; pg8::StaticOrder S; S.init(MTOK, DM, G, bx);
          pg8::EpiResid<false> E{HB, HB, LOP, ssq3, nullptr, nullptr, 0.5f, 0.f}; pg8::gemm_phase(lds, wave_s, g, S, E); }
        XSYNC();
        { pg8::Gemm g{HB, Wb + W_PG, MTOK, DM, DM, DM}; pg8::StaticOrder S; S.init(MTOK, DM, G, bx);
          pg8::EpiResid<true> E{HB, QA, LOP, ssq4, ssq3, PPJ, 1.0f, 0.f}; pg8::gemm_phase(lds, wave_s, g, S, E); }
        XSYNC();
    }
    {
        FRESH_IDS
        const float* fg = a.in[27]; const float* ssqf = PH0;
        bf16_t* LOC = ACT;
#pragma nounroll
        for (int stage = 0; stage < 2; ++stage) {
            const int mbeg = stage * (MTOK / 2);
            const bf16_t* lsrc = stage ? (LOC - (size_t)(MTOK / 2) * DM) : LOP;
            for (int m = mbeg + gw; m < mbeg + MTOK / 2; m += NGW) {
                f32x4* hr = (f32x4*)(Hf + (size_t)m * DM) + lane; const u32x2* hb = (const u32x2*)(QA + (size_t)m * DM) + lane; const u32x2* lb = (const u32x2*)(lsrc + (size_t)m * DM) + lane;
                const f32x4* pp_ = (const f32x4*)(ssqf + (size_t)m * 16); const f32x4 q0_ = pp_[0], q1_ = pp_[1], q2_ = pp_[2], q3_ = pp_[3];
                const float tot_ = (((q0_[0] + q0_[1]) + (q0_[2] + q0_[3])) + ((q1_[0] + q1_[1]) + (q1_[2] + q1_[3]))) + (((q2_[0] + q2_[1]) + (q2_[2] + q2_[3])) + ((q3_[0] + q3_[1]) + (q3_[2] + q3_[3])));
                const float rs = rsqrtf(tot_ * (1.f / 1024.f) + EPS);
#pragma unroll
                for (int j = 0; j < 4; ++j) { const f32x4 gn = *((const f32x4*)fg + lane + 64 * j); const u32x2 wh = hb[64 * j], wl = lb[64 * j];
                    f32x4 v = (f32x4){bflo(wh.x) + bflo(wl.x), bfhi(wh.x) + bfhi(wl.x), bflo(wh.y) + bflo(wl.y), bfhi(wh.y) + bfhi(wl.y)}; v = v * rs * gn; hr[64 * j] = v; }
            }
            if (stage == 0) {
                const u32x4* src = (const u32x4*)(LOP + (size_t)(MTOK / 2) * DM); u32x4* dst = (u32x4*)LOC;
                const int gt = gw * 64 + lane, NGT = NGW * 64;
                for (int i = gt; i < (MTOK / 2) * DM / 8; i += NGT) dst[i] = src[i];
                XSYNC();
            }
        }
    }
}

constexpr int LDS_BYTES = 147456;

extern "C" void kernel_launch(void* const* d_in, const int* in_sizes, int n_in, void* d_out, int out_size, void* d_ws, size_t ws_size, hipStream_t stream) {
    static int grid = 0;
    if (grid == 0) {
        if (n_in != 28 || out_size != MTOK * DM || ws_size < WS_END) { fprintf(stderr, "kernel_launch: unexpected shapes (n_in %d out %d ws %zu)\n", n_in, out_size, ws_size); grid = -1; return; }
        int dev = 0, cus = 0, per_cu = 0;
        hipGetDevice(&dev);
        hipDeviceGetAttribute(&cus, hipDeviceAttributeMultiprocessorCount, dev);
        hipFuncSetAttribute((const void*)fwd_megakernel, hipFuncAttributeMaxDynamicSharedMemorySize, LDS_BYTES);
        hipOccupancyMaxActiveBlocksPerMultiprocessor(&per_cu, (const void*)fwd_megakernel, 512, LDS_BYTES);
        if (per_cu < 1) per_cu = 1;
        if (per_cu > 1) per_cu = 1;
        grid = cus * per_cu;
        if (grid > 256) grid = 256;
        (void)hipGetLastError();
    }
    if (grid < 0) return;
    Args a{};
    for (int i = 0; i < 28; ++i) a.in[i] = (const float*)d_in[i];
    a.out = (float*)d_out; a.ws = (unsigned char*)d_ws;
    (void)hipMemsetAsync((char*)d_ws + WS_BAR, 0, 16384, stream);
    void* kargs[] = {&a};
    hipError_t e = hipLaunchCooperativeKernel((const void*)fwd_megakernel, dim3(grid), dim3(512), kargs, LDS_BYTES, stream);
    if (e != hipSuccess) fprintf(stderr, "cooperative launch failed: %s (grid %d)\n", hipGetErrorString(e), grid);
}
```
